# Optimizing an MI355X kernel written in HIP

```python
import math
import jax, jax.numpy as jnp
from jax import lax
import numpy as np

D_MODEL = 2048
BATCH = 4
SEQ = 2048
DEPTH = 4

GRID_W = 64
CTX_LEN = 256

GLA_HEADS = 4
GLA_DK = 128
GLA_DV = 256
GLA_QK = GLA_HEADS * GLA_DK
GLA_V = GLA_HEADS * GLA_DV
GLA_GATE_RANK = 16
GLA_GATE_TAU = 16.0
GLA_CHUNK = 64
S5_WIDTH = 768
S5_GROUP = 16
S5_GROUPS = S5_WIDTH // S5_GROUP
S5_STATE = 64
ATTN_Q_HEADS = 8
ATTN_KV_HEADS = 2
ATTN_HEAD_DIM = 128
ATTN_Q = ATTN_Q_HEADS * ATTN_HEAD_DIM
ATTN_KV = ATTN_KV_HEADS * ATTN_HEAD_DIM
ATTN_BLOCK = 128
ROPE_THETA = 10000.0
D_FF = ((8 * D_MODEL + 3 * 256 - 1) // (3 * 256)) * 256
IN_SPLITS = (GLA_QK, GLA_QK, GLA_V, GLA_V, GLA_GATE_RANK, S5_WIDTH, ATTN_Q, ATTN_KV, ATTN_KV, 3 * D_MODEL)
IN_WIDTH = 2 * GLA_QK + 2 * GLA_V + GLA_GATE_RANK + S5_WIDTH + ATTN_Q + 2 * ATTN_KV + 3 * D_MODEL
DN_ALPHA = (2 * DEPTH) ** 0.25
DN_BETA = (8 * DEPTH) ** -0.25
EPS = 1e-6

kernel_name = "hybrid_gla_s5_gqa_prefix_dit"

F32 = jnp.float32


def layer_norm(x, w, b):
    xf = x.astype(F32)
    mu = jnp.mean(xf, -1, keepdims=True)
    var = jnp.mean(jnp.square(xf - mu), -1, keepdims=True)
    return ((xf - mu) * lax.rsqrt(var + EPS) * w + b).astype(x.dtype)


def rms_norm(x, w):
    xf = x.astype(F32)
    return (xf * lax.rsqrt(jnp.mean(xf * xf, -1, keepdims=True) + EPS) * w).astype(x.dtype)


def modulate(h, shift, scale):
    return h * (1 + scale) + shift


def post_norm(x, y, w, b):
    return layer_norm(DN_ALPHA * x + y, w, b)


def axial_rope(n_rows):
    rows = jnp.repeat(jnp.arange(n_rows), GRID_W).astype(F32)
    cols = jnp.tile(jnp.arange(GRID_W), n_rows).astype(F32)
    n_freq = ATTN_HEAD_DIM // 4
    inv = ROPE_THETA ** (-jnp.arange(n_freq, dtype=F32) / n_freq)
    ang = jnp.concatenate([rows[:, None] * inv, cols[:, None] * inv], -1)
    return jnp.cos(ang)[:, None, :], jnp.sin(ang)[:, None, :]


def apply_rope(x, cos, sin):
    xf = x.astype(F32).reshape(x.shape[:-1] + (x.shape[-1] // 2, 2))
    x0, x1 = xf[..., 0], xf[..., 1]
    out = jnp.stack([x0 * cos - x1 * sin, x0 * sin + x1 * cos], -1)
    return out.reshape(x.shape).astype(x.dtype)


def attend(q, k, v):
    s = jnp.einsum('bqhgd,bkhd->bhgqk', q, k, preferred_element_type=F32) * (ATTN_HEAD_DIM ** -0.5)
    p = jax.nn.softmax(s, axis=-1).astype(v.dtype)
    return jnp.einsum('bhgqk,bkhd->bqhgd', p, v)


def gqa_blocks(q, k, v):
    bsz, t = q.shape[:2]
    grp = ATTN_Q_HEADS // ATTN_KV_HEADS
    qb = q.reshape(bsz, t // ATTN_BLOCK, ATTN_BLOCK, ATTN_KV_HEADS, grp, ATTN_HEAD_DIM).swapaxes(0, 1)
    ob = lax.map(lambda qq: attend(qq, k, v), qb)
    return ob.swapaxes(0, 1).reshape(bsz, t, ATTN_Q)


def gla_chunked(q, k, v, log_a, s0):
    bsz, t, nh, _ = q.shape
    dv = v.shape[-1]
    n = t // GLA_CHUNK
    mask = jnp.tril(jnp.ones((GLA_CHUNK, GLA_CHUNK), bool))

    def to_chunks(z):
        return z.reshape(bsz, n, GLA_CHUNK, nh, z.shape[-1]).swapaxes(0, 1)

    def step(s, inp):
        qc, kc, vc, ac = inp
        b = jnp.cumsum(ac, axis=1)
        qe = qc * jnp.exp(b)
        ke = kc * jnp.exp(-b)
        att = jnp.where(mask, jnp.einsum('bihd,bjhd->bhij', qe, ke), 0.0)
        o = jnp.einsum('bhij,bjhv->bihv', att, vc) + jnp.einsum('bihd,bhdv->bihv', qe, s)
        b_last = b[:, -1]
        kd = kc * jnp.exp(b_last[:, None] - b)
        s = jnp.exp(b_last)[..., None] * s + jnp.einsum('bjhd,bjhv->bhdv', kd, vc)
        return s, o

    s_fin, o = lax.scan(step, s0, (to_chunks(q), to_chunks(k), to_chunks(v), to_chunks(log_a)))
    return o.swapaxes(0, 1).reshape(bsz, t, nh, dv), s_fin


def gla_bidirectional(q, k, v, glr, w_gate, b_gate, n_ctx):
    q, k, v = q.astype(F32), k.astype(F32), v.astype(F32)
    bsz, n_tok, nh, dk = q.shape
    dv = v.shape[-1]
    outs = []
    for d in range(2):
        log_a = jax.nn.log_sigmoid((glr @ w_gate[d] + b_gate[d]).astype(F32)) / GLA_GATE_TAU
        log_a = log_a.reshape(bsz, n_tok, nh, dk)
        ctx_in = [z[:, :n_ctx] for z in (q, k, v, log_a)]
        lat_in = [z[:, n_ctx:] for z in (q, k, v, log_a)]
        if d == 1:
            ctx_in = [jnp.flip(z, 1) for z in ctx_in]
            lat_in = [jnp.flip(z, 1) for z in lat_in]
        s0 = jnp.zeros((bsz, nh, dk, dv), F32)
        o_c, s_c = gla_chunked(*ctx_in, s0)
        o_l, _ = gla_chunked(*lat_in, s_c)
        if d == 1:
            o_c, o_l = jnp.flip(o_c, 1), jnp.flip(o_l, 1)
        outs.append(jnp.concatenate([o_c, o_l], 1))
    return outs[0] + outs[1]


def s5_discretise(lam_re, lam_im, log_dt):
    lam_re, lam_im = lam_re.astype(F32), lam_im.astype(F32)
    dt = jnp.exp(log_dt.astype(F32))[:, None]
    mag = jnp.exp(lam_re * dt)
    a_re, a_im = mag * jnp.cos(lam_im * dt), mag * jnp.sin(lam_im * dt)
    den = lam_re * lam_re + lam_im * lam_im
    nr, ni = a_re - 1, a_im
    k_re = (nr * lam_re + ni * lam_im) / den
    k_im = (ni * lam_re - nr * lam_im) / den
    return a_re, a_im, k_re, k_im


def s5_scan(bu_re, bu_im, a_re, a_im, s0_re, s0_im, reverse):
    idx = -1 if reverse else 0
    bu_re = bu_re.at[:, idx].add(a_re * s0_re - a_im * s0_im)
    bu_im = bu_im.at[:, idx].add(a_re * s0_im + a_im * s0_re)
    t = bu_re.shape[1]
    ar = jnp.broadcast_to(a_re, (1, t) + a_re.shape)
    ai = jnp.broadcast_to(a_im, (1, t) + a_im.shape)

    def combine(e1, e2):
        a1r, a1i, b1r, b1i = e1
        a2r, a2i, b2r, b2i = e2
        return (a2r * a1r - a2i * a1i, a2r * a1i + a2i * a1r,
                a2r * b1r - a2i * b1i + b2r, a2r * b1i + a2i * b1r + b2i)

    _, _, xr, xi = lax.associative_scan(combine, (ar, ai, bu_re, bu_im), axis=1, reverse=reverse)
    return xr, xi


def s5_bidirectional(u, n_ctx, lam_re, lam_im, log_dt, b_re, b_im, c_re, c_im, d_skip):
    bsz, n_tok, _ = u.shape
    uf = u.astype(F32).reshape(bsz, n_tok, S5_GROUPS, S5_GROUP)
    bu_re = jnp.einsum('btgc,gpc->btgp', uf, b_re.astype(F32))
    bu_im = jnp.einsum('btgc,gpc->btgp', uf, b_im.astype(F32))
    y = uf * d_skip.astype(F32).reshape(S5_GROUPS, S5_GROUP)
    zeros = jnp.zeros((bsz, S5_GROUPS, S5_STATE), F32)
    for d in range(2):
        rev = d == 1
        a_re, a_im, k_re, k_im = s5_discretise(lam_re[d], lam_im[d], log_dt[d])
        xr = k_re * bu_re - k_im * bu_im
        xi = k_re * bu_im + k_im * bu_re
        cr, ci = s5_scan(xr[:, :n_ctx], xi[:, :n_ctx], a_re, a_im, zeros, zeros, rev)
        end = 0 if rev else -1
        lr, li = s5_scan(xr[:, n_ctx:], xi[:, n_ctx:], a_re, a_im, cr[:, end], ci[:, end], rev)
        sr = jnp.concatenate([cr, lr], 1)
        si = jnp.concatenate([ci, li], 1)
        y = y + jnp.einsum('btgp,gcp->btgc', sr, c_re[d].astype(F32)) \
              - jnp.einsum('btgp,gcp->btgc', si, c_im[d].astype(F32))
    return y.reshape(bsz, n_tok, S5_WIDTH)


def token_mixers(h, n_ctx, keep_ctx, cos, sin, w_in, w_gla_gate, b_gla_gate, gla_norm_w,
                 s5_lam_re, s5_lam_im, s5_log_dt, s5_b_re, s5_b_im, s5_c_re, s5_c_im, s5_d,
                 w_s5_glu, q_norm_w, k_norm_w, w_proj_gla, w_proj_s5, w_proj_attn, w_out):
    bsz, n_tok, _ = h.shape
    cuts = [int(s) for s in np.cumsum(IN_SPLITS)[:-1]]
    gq, gk, gv, gr, glr, su, aq, ak, av, bg = jnp.split(h @ w_in, cuts, axis=-1)
    lo = 0 if keep_ctx else n_ctx

    def heads(z, nh):
        return z.reshape(bsz, n_tok, nh, -1)

    o = gla_bidirectional(heads(gq, GLA_HEADS) * (GLA_DK ** -0.5), heads(gk, GLA_HEADS),
                          heads(gv, GLA_HEADS), glr, w_gla_gate, b_gla_gate, n_ctx)[:, lo:]
    mu = jnp.mean(o, -1, keepdims=True)
    var = jnp.mean(jnp.square(o - mu), -1, keepdims=True)
    o = (o - mu) * lax.rsqrt(var + EPS) * gla_norm_w.astype(F32).reshape(GLA_HEADS, GLA_DV)
    o_gla = o.reshape(bsz, n_tok - lo, GLA_V).astype(h.dtype) * jax.nn.silu(gr[:, lo:])

    y = s5_bidirectional(su, n_ctx, s5_lam_re, s5_lam_im, s5_log_dt, s5_b_re, s5_b_im,
                         s5_c_re, s5_c_im, s5_d)[:, lo:].astype(h.dtype)
    y = jax.nn.gelu(y)
    o_s5 = y * jax.nn.sigmoid(y @ w_s5_glu)

    q = rms_norm(heads(aq, ATTN_Q_HEADS), q_norm_w)
    k = rms_norm(heads(ak, ATTN_KV_HEADS), k_norm_w)
    v = heads(av, ATTN_KV_HEADS)
    q_lat = apply_rope(q[:, n_ctx:], cos, sin)
    k_lat = apply_rope(k[:, n_ctx:], cos, sin)
    k_all = jnp.concatenate([k_lat, k[:, :n_ctx]], 1)
    v_all = jnp.concatenate([v[:, n_ctx:], v[:, :n_ctx]], 1)
    o_attn = gqa_blocks(q_lat, k_all, v_all)
    if keep_ctx:
        grp = ATTN_Q_HEADS // ATTN_KV_HEADS
        q_c = q[:, :n_ctx].reshape(bsz, n_ctx, ATTN_KV_HEADS, grp, ATTN_HEAD_DIM)
        o_c = attend(q_c, k[:, :n_ctx], v[:, :n_ctx]).reshape(bsz, n_ctx, ATTN_Q)
        o_attn = jnp.concatenate([o_c, o_attn], 1)

    g_a, g_b, g_c = jnp.split(jax.nn.sigmoid(bg[:, lo:]), 3, axis=-1)
    merged = g_a * (o_gla @ w_proj_gla) + g_b * (o_s5 @ w_proj_s5) + g_c * (o_attn @ w_proj_attn)
    return merged @ w_out


def swiglu(h, w_ffn_in, w_ffn_out):
    a, b = jnp.split(h @ w_ffn_in, 2, axis=-1)
    return (jax.nn.silu(a) * b) @ w_ffn_out


def setup_inputs(seed: int = 0) -> dict:
    key = jax.random.key(seed)
    keys = iter(jax.random.split(key, 40))

    def nrm(shape, std):
        return std * jax.random.normal(next(keys), shape, F32)

    L, D, G, P = DEPTH, D_MODEL, S5_GROUPS, S5_STATE
    lam_im = jnp.pi * jnp.arange(P, dtype=F32) + nrm((L, 2, G, P), 0.01)
    return {
        "x": nrm((BATCH, SEQ, D), 1.0),
        "c": nrm((BATCH, D), 1.0),
        "ctx": nrm((BATCH, CTX_LEN, D), 1.0),
        "c_ctx": nrm((D,), 1.0),
        "w_ada": nrm((L, D, 6 * D), 0.5 * D ** -0.5),
        "b_ada": nrm((L, 6 * D), 0.02),
        "w_in": nrm((L, D, IN_WIDTH), D ** -0.5),
        "w_gla_gate": nrm((L, 2, GLA_GATE_RANK, GLA_QK), GLA_GATE_RANK ** -0.5),
        "b_gla_gate": nrm((L, 2, GLA_QK), 0.1),
        "gla_norm_w": 1.0 + nrm((L, GLA_V), 0.02),
        "s5_lam_re": -0.5 + nrm((L, 2, G, P), 0.01),
        "s5_lam_im": lam_im,
        "s5_log_dt": jax.random.uniform(next(keys), (L, 2, G), F32, math.log(1e-3), math.log(1e-1)),
        "s5_b_re": nrm((L, G, P, S5_GROUP), (2 * S5_GROUP) ** -0.5),
        "s5_b_im": nrm((L, G, P, S5_GROUP), (2 * S5_GROUP) ** -0.5),
        "s5_c_re": nrm((L, 2, G, S5_GROUP, P), 0.5),
        "s5_c_im": nrm((L, 2, G, S5_GROUP, P), 0.5),
        "s5_d": nrm((L, S5_WIDTH), 1.0),
        "w_s5_glu": nrm((L, S5_WIDTH, S5_WIDTH), S5_WIDTH ** -0.5),
        "q_norm_w": 1.0 + nrm((L, ATTN_HEAD_DIM), 0.02),
        "k_norm_w": 1.0 + nrm((L, ATTN_HEAD_DIM), 0.02),
        "w_proj_gla": nrm((L, GLA_V, D), GLA_V ** -0.5),
        "w_proj_s5": nrm((L, S5_WIDTH, D), S5_WIDTH ** -0.5),
        "w_proj_attn": nrm((L, ATTN_Q, D), ATTN_Q ** -0.5),
        "w_out": nrm((L, D, D), DN_BETA * D ** -0.5),
        "ln1_w": 1.0 + nrm((L, D), 0.02),
        "ln1_b": nrm((L, D), 0.02),
        "ln2_w": 1.0 + nrm((L, D), 0.02),
        "ln2_b": nrm((L, D), 0.02),
        "w_ffn_in": nrm((L, D, 2 * D_FF), D ** -0.5),
        "w_ffn_out": nrm((L, D_FF, D), DN_BETA * D_FF ** -0.5),
    }


def reference(x, c, ctx, c_ctx, w_ada, b_ada, w_in, w_gla_gate, b_gla_gate, gla_norm_w,
              s5_lam_re, s5_lam_im, s5_log_dt, s5_b_re, s5_b_im, s5_c_re, s5_c_im, s5_d,
              w_s5_glu, q_norm_w, k_norm_w, w_proj_gla, w_proj_s5, w_proj_attn, w_out,
              ln1_w, ln1_b, ln2_w, ln2_b, w_ffn_in, w_ffn_out):
    n_ctx = ctx.shape[1]
    n_lat = x.shape[1]
    rows = n_lat // GRID_W
    cos, sin = axial_rope(rows)
    xc = ctx
    silu_c = jax.nn.silu(c)
    silu_cc = jax.nn.silu(c_ctx)
    for l in range(DEPTH):
        keep_ctx = l < DEPTH - 1
        mod = (silu_c @ w_ada[l] + b_ada[l])[:, None, :]
        mod_c = silu_cc @ w_ada[l] + b_ada[l]
        sh1, sc1, g1, sh2, sc2, g2 = jnp.split(mod, 6, axis=-1)
        csh1, csc1, cg1, csh2, csc2, cg2 = jnp.split(mod_c, 6, axis=-1)
        h = jnp.concatenate([modulate(xc, csh1, csc1), modulate(x, sh1, sc1)], axis=1)
        mix = token_mixers(h, n_ctx, keep_ctx, cos, sin, w_in[l], w_gla_gate[l], b_gla_gate[l],
                           gla_norm_w[l], s5_lam_re[l], s5_lam_im[l], s5_log_dt[l], s5_b_re[l],
                           s5_b_im[l], s5_c_re[l], s5_c_im[l], s5_d[l], w_s5_glu[l], q_norm_w[l],
                           k_norm_w[l], w_proj_gla[l], w_proj_s5[l], w_proj_attn[l], w_out[l])
        mix_lat = mix[:, mix.shape[1] - n_lat:]
        x = post_norm(x, g1 * mix_lat, ln1_w[l], ln1_b[l])
        x = post_norm(x, g2 * swiglu(modulate(x, sh2, sc2), w_ffn_in[l], w_ffn_out[l]), ln2_w[l], ln2_b[l])
        if keep_ctx:
            xc = post_norm(xc, cg1 * mix[:, :n_ctx], ln1_w[l], ln1_b[l])
            xc = post_norm(xc, cg2 * swiglu(modulate(xc, csh2, csc2), w_ffn_in[l], w_ffn_out[l]),
                           ln2_w[l], ln2_b[l])
    return x
```

```cpp
#include <hip/hip_runtime.h>
#include <hip/hip_bf16.h>
#include <cstdio>
#include <cstdint>

#define LAS __attribute__((address_space(3)))
typedef unsigned short bf16_t;
typedef short bf16x8 __attribute__((ext_vector_type(8)));
typedef short s16x4 __attribute__((ext_vector_type(4)));
typedef float f32x4 __attribute__((ext_vector_type(4)));
typedef float f32x2 __attribute__((ext_vector_type(2)));
typedef float f32x8 __attribute__((ext_vector_type(8)));
typedef float f32x16 __attribute__((ext_vector_type(16)));
typedef unsigned u32x4 __attribute__((ext_vector_type(4)));
typedef unsigned u32x2 __attribute__((ext_vector_type(2)));

constexpr int DM = 2048, NB = 4, SEQ = 2048, NCTX = 256, TOK = NCTX + SEQ, MROWS = NB * TOK, DEPTH = 4;
constexpr int NIN = 11776;
constexpr int YW = 11520;
constexpr int Y_GQ = 0, Y_GK = 512, Y_GV = 1024, Y_GR = 2048, Y_SU = 3072, Y_AQ = 3840, Y_AK = 4864, Y_AV = 5120, Y_BG = 5376;
constexpr int DFF = 5632, OCW = 2816;
constexpr int NMOD = 6 * DM;
constexpr int ADA_KS = 32;
constexpr float DN_ALPHA = 1.6817928305074290f;
constexpr float LN_EPS = 1e-6f;

constexpr size_t MiB = 1u << 20;
constexpr size_t WS_CTL = 0, CTL_ZERO_BYTES = 1 * MiB;
constexpr size_t WS_MODP = 1 * MiB;
constexpr size_t WS_MOD = 32 * MiB;
constexpr size_t WS_S5A = 33 * MiB;
constexpr size_t WS_S5KB = 34 * MiB;
constexpr size_t WS_S5CT = 36 * MiB;
constexpr size_t WS_GLR = 38 * MiB;
constexpr size_t WS_X = 40 * MiB;
constexpr size_t WS_Z = 112 * MiB;
constexpr size_t WS_H = 184 * MiB;
constexpr size_t WS_Y = 220 * MiB;
constexpr size_t WS_QN = 423 * MiB;
constexpr size_t WS_KN = 441 * MiB;
constexpr size_t WS_OCAT = 446 * MiB;
constexpr size_t WS_OGF = 496 * MiB, WS_OGB = 532 * MiB;
constexpr size_t WS_YSF = 568 * MiB, WS_YSB = 595 * MiB;
constexpr size_t WS_YG = 622 * MiB;
constexpr size_t WS_W = 636 * MiB;
constexpr size_t WL_IN = 0, WL_GLU = 46 * MiB, WL_CAT = 48 * MiB, WL_OUT = 59 * MiB, WL_FFI = 67 * MiB, WL_FFO = 111 * MiB, WL_STRIDE = 133 * MiB;
constexpr size_t WS_END = WS_W + 4 * WL_STRIDE;

__device__ __forceinline__ float bf2f(bf16_t b) { return __uint_as_float(((unsigned)b) << 16); }
typedef __bf16 bf16x2n __attribute__((ext_vector_type(2)));
__device__ __forceinline__ unsigned cvt_pk_bf16(float lo, float hi) { const f32x2 v = {lo, hi}; return __builtin_bit_cast(unsigned, __builtin_convertvector(v, bf16x2n)); }
__device__ __forceinline__ bf16_t f2bf(float f) { return __builtin_bit_cast(unsigned short, (__bf16)f); }
__device__ __forceinline__ float lo_bf(unsigned w) { return __uint_as_float(w << 16); }
__device__ __forceinline__ float hi_bf(unsigned w) { return __uint_as_float(w & 0xffff0000u); }
__device__ __forceinline__ float fsigmoid(float x) { return 1.0f / (1.0f + __expf(-x)); }
__device__ __forceinline__ float fsilu(float x) { return x / (1.0f + __expf(-x)); }
__device__ __forceinline__ float flogsigmoid(float x) { return fminf(x, 0.f) - log1pf(__expf(-fabsf(x))); }
__device__ __forceinline__ float fgelu_tanh(float x) { const float u = 0.7978845608028654f * (x + 0.044715f * x * x * x); const float e = __expf(2.0f * u); const float t = 1.0f - 2.0f / (e + 1.0f); return 0.5f * x * (1.0f + t); }
__device__ __forceinline__ float wave_sum(float v) {
#pragma unroll
    for (int o = 1; o < 64; o <<= 1) v += __shfl_xor(v, o);
    return v;
}
__device__ __forceinline__ int opaque(int x) { asm volatile("" : "+v"(x)); return x; }
__device__ __forceinline__ unsigned char* opaque_ptr(unsigned char* p) { asm volatile("" : "+s"(p)); return p; }
#define LDS_WAIT() asm volatile("s_waitcnt lgkmcnt(0)" ::: "memory")
#define VM_WAIT() asm volatile("s_waitcnt vmcnt(0)" ::: "memory")
namespace pg8 {
constexpr int BM = 256, BK = 64, HALF = 128, HTB = HALF * BK * 2  , STAGE_BYTES = 8 * HTB, NXCD = 8, WGM = 8;
__host__ __device__ __forceinline__ int lds_byte(int r, int c) { const int st = (r >> 4) * 2 + (c >> 5), rr = r & 15, cc = c & 31, ob = rr * 64 + cc * 2; return st * 1024 + (ob ^ (((ob >> 9) & 1) << 5)); }
__host__ __device__ __forceinline__ void stage_rc(int b, int& R, int& C) { const int st = b / 1024, sb = b % 1024, swz = sb ^ (((sb >> 9) & 1) << 5); R = (st >> 1) * 16 + swz / 64; C = (st & 1) * 32 + (swz % 64) / 2; }
__host__ __device__ __forceinline__ int perm32(int rho) { const int n = rho >> 4, i = rho & 15; return 8 * (i >> 2) + 4 * n + (i & 3); }

struct Unit { int pm, pn; };
struct Gemm { const bf16_t* A; const bf16_t* Bt; int M, N, K, lda, ldb; };

struct StaticOrder {
    int nM, nN, nwg, G, c;
    __host__ __device__ void init(int M, int N, int G_, int c_) { nM = M / BM; nN = N / BM; nwg = nM * nN; G = G_; c = c_; }
    __host__ __device__ bool next(int i, Unit& u) const {
        const long L = (long)i * G + c; if (L >= nwg) return false;
        int wgid = (int)L; { const int q = nwg / NXCD, r = nwg % NXCD, xcd = wgid % NXCD, off = wgid / NXCD; wgid = (xcd < r ? xcd * (q + 1) : r * (q + 1) + (xcd - r) * q) + off; }
        const int nig = WGM * nN, gid = wgid / nig, fm = gid * WGM, gsz = (nM - fm) < WGM ? (nM - fm) : WGM;
        u.pm = fm + ((wgid % nig) % gsz); u.pn = (wgid % nig) / gsz; return true;
    }
    __device__ __forceinline__ void a_ready(const Unit&) const {}
    __device__ __forceinline__ void done(const Unit&) const {}
};

template <class Epi, class Sched, bool ALIGN_EPI = false, bool SP2 = false>
__device__ __forceinline__ void gemm_phase(LAS unsigned char* lds, const Gemm g, const Sched& S, const Epi& E) {
    const int tid = opaque(threadIdx.x), wid = __builtin_amdgcn_readfirstlane(tid >> 6), lane = tid & 63, wr = wid >> 2, wc = wid & 3, fr = lane & 15, fq = lane >> 4;
    const int K = g.K, nt = K / BK;
    unsigned voffA[2], voffB[2];
#pragma unroll
    for (int i = 0; i < 2; ++i) { int R, C; stage_rc(tid * 16 + i * 8192, R, C); const int Rb = Epi::PERM ? ((R & ~31) + perm32(R & 31)) : R;
        voffA[i] = (unsigned)(R * g.lda + C) * 2u; voffB[i] = (unsigned)(Rb * g.ldb + C) * 2u; }
    const size_t kstep = (size_t)(BK * 2);
    const size_t hstepA = (size_t)HALF * g.lda * 2, hstepB = (size_t)HALF * g.ldb * 2;
    const size_t tstepA = 2 * hstepA, tstepB = 2 * hstepB;
    const unsigned ldsw = (unsigned)wid * 1024u;
    const int aoff = lds_byte(wr * 64 + fr, fq * 8), boff = lds_byte(wc * 32 + fr, fq * 8);
#define PG8_SA(b, h) (((b) * 2 + (h)) * HTB)
#define PG8_SB(b, h) ((4 + (b) * 2 + (h)) * HTB)
#define PG8_STAGE(bufoff, gbase, voff) do { _Pragma("unroll") for (int _i = 0; _i < 2; ++_i) \
        __builtin_amdgcn_global_load_lds((const unsigned*)((const char*)(gbase) + (voff)[_i]), (LAS unsigned*)(lds + (bufoff) + ldsw + _i * 8192), 16, 0, 0); } while (0)
#define PG8_LDA(dst, b, h) do { _Pragma("unroll") for (int m = 0; m < 4; ++m) _Pragma("unroll") for (int k = 0; k < 2; ++k) dst[m][k] = *(const LAS bf16x8*)(lds + PG8_SA(b, h) + aoff + m * 2048 + k * 1024); } while (0)
#define PG8_LDB(dst, b, h) do { _Pragma("unroll") for (int n = 0; n < 2; ++n) _Pragma("unroll") for (int k = 0; k < 2; ++k) dst[n][k] = *(const LAS bf16x8*)(lds + PG8_SB(b, h) + boff + n * 2048 + k * 1024); } while (0)
#define PG8_MMA(ai, bj, At, Bt) do { __builtin_amdgcn_s_setprio(1); _Pragma("unroll") for (int m = 0; m < 4; ++m) _Pragma("unroll") for (int n = 0; n < 2; ++n) _Pragma("unroll") for (int k = 0; k < 2; ++k) \
        acc[ai][bj][m][n] = __builtin_amdgcn_mfma_f32_16x16x32_bf16(Bt[n][k], At[m][k], acc[ai][bj][m][n], 0, 0, 0); __builtin_amdgcn_s_setprio(0); } while (0)
#define PG8_WAIT_V(n) asm volatile("s_waitcnt vmcnt(" #n ")" ::: "memory")
#define PG8_WAIT_L(n) asm volatile("s_waitcnt lgkmcnt(" #n ")" ::: "memory")
#define PG8_BAR __builtin_amdgcn_s_barrier()
#define PG8_SCHED __builtin_amdgcn_sched_barrier(0)
    Unit cur, nxt; int ui = 0;
    if (!S.next(0, cur)) return;
    f32x4 acc[2][2][4][2];
#pragma unroll
    for (int a = 0; a < 2; ++a)
#pragma unroll
        for (int b = 0; b < 2; ++b)
#pragma unroll
            for (int m = 0; m < 4; ++m)
#pragma unroll
                for (int n = 0; n < 2; ++n) acc[a][b][m][n] = (f32x4){0.f, 0.f, 0.f, 0.f};
    bf16x8 At[4][2], B0[2][2], B1[2][2];
    const char* cA = (const char*)g.A + (size_t)cur.pm * tstepA; const char* cB = (const char*)g.Bt + (size_t)cur.pn * tstepB;
    S.a_ready(cur);
    if constexpr (SP2) {
        PG8_STAGE(PG8_SB(0, 0), cB, voffB); PG8_STAGE(PG8_SB(0, 1), cB + hstepB, voffB); PG8_STAGE(PG8_SA(0, 0), cA, voffA); PG8_STAGE(PG8_SA(0, 1), cA + hstepA, voffA);
        if (wr == 1) PG8_BAR;
        PG8_WAIT_V(2); PG8_BAR;
        PG8_STAGE(PG8_SB(1, 0), cB + kstep, voffB); PG8_STAGE(PG8_SA(1, 0), cA + kstep, voffA); PG8_STAGE(PG8_SB(1, 1), cB + hstepB + kstep, voffB);
        PG8_WAIT_V(6); PG8_BAR;
    } else {
        PG8_STAGE(PG8_SB(0, 0), cB, voffB); PG8_STAGE(PG8_SA(0, 0), cA, voffA); PG8_STAGE(PG8_SB(0, 1), cB + hstepB, voffB); PG8_STAGE(PG8_SA(0, 1), cA + hstepA, voffA);
        if (wr == 1) PG8_BAR;
        PG8_WAIT_V(4); PG8_BAR;
        PG8_STAGE(PG8_SB(1, 0), cB + kstep, voffB); PG8_STAGE(PG8_SA(1, 0), cA + kstep, voffA); PG8_STAGE(PG8_SB(1, 1), cB + hstepB + kstep, voffB);
        PG8_WAIT_V(6); PG8_BAR;
    }
    for (;;) {
        const bool has_next = S.next(ui + 1, nxt);
        const char* nA = has_next ? (const char*)g.A + (size_t)nxt.pm * tstepA : cA; const char* nB = has_next ? (const char*)g.Bt + (size_t)nxt.pn * tstepB : cB;
        for (int t = 0; t < nt; t += 2) {
            const bool last = (t == nt - 2);
            const char* a1 = cA + (size_t)(t + 1) * kstep;
            const char* a2 = last ? nA : cA + (size_t)(t + 2) * kstep; const char* b2 = last ? nB : cB + (size_t)(t + 2) * kstep;
            const char* a3 = a2 + kstep; const char* b3 = b2 + kstep;
            if (last && has_next) S.a_ready(nxt);
            if constexpr (SP2) {
            PG8_LDB(B0, 0, 0); PG8_LDB(B1, 0, 1); PG8_SCHED; PG8_LDA(At, 0, 0); PG8_STAGE(PG8_SA(1, 1), a1 + hstepA, voffA);
            PG8_WAIT_V(8); PG8_WAIT_L(0); PG8_BAR; PG8_MMA(0, 0, At, B0); PG8_MMA(0, 1, At, B1); PG8_BAR; PG8_SCHED;
            PG8_LDA(At, 0, 1); PG8_STAGE(PG8_SB(0, 0), b2, voffB); PG8_STAGE(PG8_SB(0, 1), b2 + hstepB, voffB); PG8_STAGE(PG8_SA(0, 0), a2, voffA);
            PG8_WAIT_V(8); PG8_WAIT_L(0); PG8_BAR; PG8_MMA(1, 0, At, B0); PG8_MMA(1, 1, At, B1); PG8_BAR; PG8_SCHED;
            PG8_LDB(B0, 1, 0); PG8_LDB(B1, 1, 1); PG8_SCHED; PG8_LDA(At, 1, 0); PG8_STAGE(PG8_SA(0, 1), a2 + hstepA, voffA);
            PG8_WAIT_V(8); PG8_WAIT_L(0); PG8_BAR; PG8_MMA(0, 0, At, B0); PG8_MMA(0, 1, At, B1); PG8_BAR; PG8_SCHED;
            PG8_LDA(At, 1, 1); PG8_STAGE(PG8_SB(1, 0), b3, voffB); PG8_STAGE(PG8_SB(1, 1), b3 + hstepB, voffB); PG8_STAGE(PG8_SA(1, 0), a3, voffA);
            PG8_WAIT_V(8); PG8_WAIT_L(0); PG8_BAR; PG8_MMA(1, 0, At, B0); PG8_MMA(1, 1, At, B1); PG8_BAR; PG8_SCHED;
            } else {
            PG8_LDB(B0, 0, 0); PG8_SCHED; PG8_LDA(At, 0, 0); PG8_STAGE(PG8_SA(1, 1), a1 + hstepA, voffA);
            PG8_WAIT_L(8); PG8_BAR; PG8_WAIT_L(0); PG8_MMA(0, 0, At, B0); PG8_BAR; PG8_SCHED;
            PG8_LDB(B1, 0, 1); PG8_STAGE(PG8_SB(0, 0), b2, voffB);
            PG8_BAR; PG8_WAIT_L(0); PG8_MMA(0, 1, At, B1); PG8_BAR;
            PG8_LDA(At, 0, 1); PG8_STAGE(PG8_SA(0, 0), a2, voffA);
            PG8_BAR; PG8_WAIT_L(0); PG8_MMA(1, 0, At, B0); PG8_BAR; PG8_SCHED;
            PG8_STAGE(PG8_SB(0, 1), b2 + hstepB, voffB);
            PG8_WAIT_V(6); PG8_BAR; PG8_MMA(1, 1, At, B1); PG8_BAR;
            PG8_LDB(B0, 1, 0); PG8_SCHED; PG8_LDA(At, 1, 0); PG8_STAGE(PG8_SA(0, 1), a2 + hstepA, voffA);
            PG8_WAIT_L(8); PG8_BAR; PG8_WAIT_L(0); PG8_MMA(0, 0, At, B0); PG8_BAR; PG8_SCHED;
            PG8_LDB(B1, 1, 1); PG8_STAGE(PG8_SB(1, 0), b3, voffB);
            PG8_BAR; PG8_WAIT_L(0); PG8_MMA(0, 1, At, B1); PG8_BAR;
            PG8_LDA(At, 1, 1); PG8_STAGE(PG8_SA(1, 0), a3, voffA);
            PG8_BAR; PG8_WAIT_L(0); PG8_MMA(1, 0, At, B0); PG8_BAR; PG8_SCHED;
            PG8_STAGE(PG8_SB(1, 1), b3 + hstepB, voffB);
            PG8_WAIT_V(6); PG8_BAR; PG8_MMA(1, 1, At, B1); PG8_BAR;
            }
        }
        if constexpr (ALIGN_EPI) { if (wr == 0) PG8_BAR; }
        E(acc, cur, wr, wc, fr, fq); S.done(cur);
        if (!has_next) break;
#pragma unroll
        for (int a = 0; a < 2; ++a)
#pragma unroll
            for (int b = 0; b < 2; ++b)
#pragma unroll
                for (int m = 0; m < 4; ++m)
#pragma unroll
                    for (int n = 0; n < 2; ++n) acc[a][b][m][n] = (f32x4){0.f, 0.f, 0.f, 0.f};
        cur = nxt; cA = nA; cB = nB; ++ui;
        if constexpr (ALIGN_EPI) { if (wr == 1) PG8_BAR; }
    }
    PG8_WAIT_V(0);
    if constexpr (!ALIGN_EPI) { if (wr == 0) PG8_BAR; }
    PG8_BAR;
#undef PG8_SA
#undef PG8_SB
#undef PG8_STAGE
#undef PG8_LDA
#undef PG8_LDB
#undef PG8_MMA
#undef PG8_WAIT_V
#undef PG8_WAIT_L
#undef PG8_BAR
#undef PG8_SCHED
}
}
namespace pg8 {
struct EpiInProj {
    static constexpr bool PERM = true;
    bf16_t* Y; float* GLR;
    __device__ __forceinline__ void operator()(const f32x4 (&acc)[2][2][4][2], const Unit& u, int wr, int wc, int fr, int fq) const {
        const int colt = u.pn * BM, row0 = u.pm * BM + wr * 64 + fr;
        if (colt >= YW) {
            if (wc == 0 && fq < 2) {
#pragma unroll
                for (int ai = 0; ai < 2; ++ai)
#pragma unroll
                    for (int m = 0; m < 4; ++m) { float* p = GLR + (size_t)(row0 + ai * HALF + m * 16) * 16 + 8 * fq;
                        *(f32x4*)p = acc[ai][0][m][0]; *(f32x4*)(p + 4) = acc[ai][0][m][1]; }
            }
            return;
        }
        const int mode = (colt < Y_GK) ? 1 : ((colt >= Y_GR && colt < Y_SU) ? 2 : (colt >= Y_BG ? 3 : 0));
        const int col0 = colt + wc * 32 + 8 * fq;
#pragma unroll
        for (int ai = 0; ai < 2; ++ai)
#pragma unroll
            for (int m = 0; m < 4; ++m) { bf16_t* rowp = Y + (size_t)(row0 + ai * HALF + m * 16) * YW + col0;
#pragma unroll
                for (int bj = 0; bj < 2; ++bj) { f32x4 v0 = acc[ai][bj][m][0], v1 = acc[ai][bj][m][1];
                    if (mode == 1) { v0 *= 0.08838834764831845f; v1 *= 0.08838834764831845f; }
                    else if (mode == 2) {
#pragma unroll
                        for (int j = 0; j < 4; ++j) { v0[j] = fsilu(v0[j]); v1[j] = fsilu(v1[j]); } }
                    else if (mode == 3) {
#pragma unroll
                        for (int j = 0; j < 4; ++j) { v0[j] = fsigmoid(v0[j]); v1[j] = fsigmoid(v1[j]); } }
                    u32x4 w; w.x = cvt_pk_bf16(v0[0], v0[1]); w.y = cvt_pk_bf16(v0[2], v0[3]); w.z = cvt_pk_bf16(v1[0], v1[1]); w.w = cvt_pk_bf16(v1[2], v1[3]);
                    *(u32x4*)(rowp + bj * HALF) = w; } }
    }
};
struct EpiGlu {
    static constexpr bool PERM = true;
    const bf16_t* YG; bf16_t* OC;
    __device__ __forceinline__ void operator()(const f32x4 (&acc)[2][2][4][2], const Unit& u, int wr, int wc, int fr, int fq) const {
        const int row0 = u.pm * BM + wr * 64 + fr, col0 = u.pn * BM + wc * 32 + 8 * fq;
#pragma unroll
        for (int ai = 0; ai < 2; ++ai)
#pragma unroll
            for (int m = 0; m < 4; ++m) { const size_t row = (size_t)(row0 + ai * HALF + m * 16);
#pragma unroll
                for (int bj = 0; bj < 2; ++bj) { const f32x4 v0 = acc[ai][bj][m][0], v1 = acc[ai][bj][m][1];
                    const u32x4 y = *(const u32x4*)(YG + row * 768 + col0 + bj * HALF);
                    u32x4 w;
                    w.x = cvt_pk_bf16(lo_bf(y.x) * fsigmoid(v0[0]), hi_bf(y.x) * fsigmoid(v0[1])); w.y = cvt_pk_bf16(lo_bf(y.y) * fsigmoid(v0[2]), hi_bf(y.y) * fsigmoid(v0[3]));
                    w.z = cvt_pk_bf16(lo_bf(y.z) * fsigmoid(v1[0]), hi_bf(y.z) * fsigmoid(v1[1])); w.w = cvt_pk_bf16(lo_bf(y.w) * fsigmoid(v1[2]), hi_bf(y.w) * fsigmoid(v1[3]));
                    *(u32x4*)(OC + row * OCW + 1024 + col0 + bj * HALF) = w; } }
    }
};
template <int STAGE> struct EpiMerge {
    static constexpr bool PERM = true;
    const bf16_t* Y; float* T; bf16_t* O;
    __device__ __forceinline__ void operator()(const f32x4 (&acc)[2][2][4][2], const Unit& u, int wr, int wc, int fr, int fq) const {
        const int row0 = u.pm * BM + wr * 64 + fr, col0 = u.pn * BM + wc * 32 + 8 * fq;
#pragma unroll
        for (int ai = 0; ai < 2; ++ai)
#pragma unroll
            for (int m = 0; m < 4; ++m) { const size_t row = (size_t)(row0 + ai * HALF + m * 16);
#pragma unroll
                for (int bj = 0; bj < 2; ++bj) { const int c = col0 + bj * HALF;
                    const u32x4 gt = *(const u32x4*)(Y + row * YW + Y_BG + STAGE * 2048 + c);
                    f32x4 v0 = acc[ai][bj][m][0], v1 = acc[ai][bj][m][1];
                    v0[0] *= lo_bf(gt.x); v0[1] *= hi_bf(gt.x); v0[2] *= lo_bf(gt.y); v0[3] *= hi_bf(gt.y);
                    v1[0] *= lo_bf(gt.z); v1[1] *= hi_bf(gt.z); v1[2] *= lo_bf(gt.w); v1[3] *= hi_bf(gt.w);
                    float* tp = T + row * DM + c;
                    if (STAGE > 0) { v0 += *(const f32x4*)tp; v1 += *(const f32x4*)(tp + 4); }
                    if (STAGE < 2) { *(f32x4*)tp = v0; *(f32x4*)(tp + 4) = v1; }
                    else { u32x4 w; w.x = cvt_pk_bf16(v0[0], v0[1]); w.y = cvt_pk_bf16(v0[2], v0[3]); w.z = cvt_pk_bf16(v1[0], v1[1]); w.w = cvt_pk_bf16(v1[2], v1[3]);
                        *(u32x4*)(O + row * DM + c) = w; } } }
    }
};
struct EpiResid {
    static constexpr bool PERM = true;
    const float* X; float* Z; const float* gate;
    __device__ __forceinline__ void operator()(const f32x4 (&acc)[2][2][4][2], const Unit& u, int wr, int wc, int fr, int fq) const {
        const int row0 = u.pm * BM + wr * 64 + fr, col0 = u.pn * BM + wc * 32 + 8 * fq;
        const int cond = (u.pm % 9 == 0) ? 4 : (u.pm / 9);
        const float* gp = gate + (size_t)cond * NMOD + col0;
        f32x4 g[2][2];
#pragma unroll
        for (int bj = 0; bj < 2; ++bj) { g[bj][0] = *(const f32x4*)(gp + bj * HALF); g[bj][1] = *(const f32x4*)(gp + bj * HALF + 4); }
#pragma unroll
        for (int ai = 0; ai < 2; ++ai)
#pragma unroll
            for (int m = 0; m < 4; ++m) { const size_t off = (size_t)(row0 + ai * HALF + m * 16) * DM + col0;
#pragma unroll
                for (int bj = 0; bj < 2; ++bj) {
                    const f32x4 x0 = *(const f32x4*)(X + off + bj * HALF), x1 = *(const f32x4*)(X + off + bj * HALF + 4);
                    *(f32x4*)(Z + off + bj * HALF) = x0 * DN_ALPHA + g[bj][0] * acc[ai][bj][m][0];
                    *(f32x4*)(Z + off + bj * HALF + 4) = x1 * DN_ALPHA + g[bj][1] * acc[ai][bj][m][1]; } }
    }
};
struct EpiSwiglu {
    static constexpr bool PERM = true;
    bf16_t* ACT;
    __device__ __forceinline__ void operator()(const f32x4 (&acc)[2][2][4][2], const Unit& u, int wr, int wc, int fr, int fq) const {
        const int row0 = u.pm * BM + wr * 64 + fr, col0 = u.pn * HALF + wc * 32 + 8 * fq;
#pragma unroll
        for (int ai = 0; ai < 2; ++ai)
#pragma unroll
            for (int m = 0; m < 4; ++m) { const f32x4 a0 = acc[ai][0][m][0], a1 = acc[ai][0][m][1], b0 = acc[ai][1][m][0], b1 = acc[ai][1][m][1];
                u32x4 w; w.x = cvt_pk_bf16(fsilu(a0[0]) * b0[0], fsilu(a0[1]) * b0[1]); w.y = cvt_pk_bf16(fsilu(a0[2]) * b0[2], fsilu(a0[3]) * b0[3]);
                w.z = cvt_pk_bf16(fsilu(a1[0]) * b1[0], fsilu(a1[1]) * b1[1]); w.w = cvt_pk_bf16(fsilu(a1[2]) * b1[2], fsilu(a1[3]) * b1[3]);
                *(u32x4*)(ACT + (size_t)(row0 + ai * HALF + m * 16) * DFF + col0) = w; }
    }
};
}
namespace att {
constexpr int D = 128, NW = 8, QBLK = 32, KVBLK = 64;
constexpr float SCALE = 0.088388347648318440f;
constexpr float THR = 8.f;
#ifndef ATT_SDEPTH
#define ATT_SDEPTH 1
#endif
constexpr int SDEPTH = ATT_SDEPTH;
constexpr int LDQ = 1024, LDK = 256, LDV = YW, LDO = OCW;
constexpr size_t SHM_V = KVBLK * D * 2, SHM_K = KVBLK * D * 2, SHM_ATTN = 2 * SHM_V + 2 * SHM_K + NW * 64 * 4;
#define KSWZ(row, colB) ((row) * 256 + ((colB) ^ (((row) & 7) << 4)))
#define SBAR() __builtin_amdgcn_sched_barrier(0)
__device__ __forceinline__ int crow(int r, int hi) { return (r & 3) + 8 * (r >> 2) + 4 * hi; }
__device__ __forceinline__ bf16x8 ld8(const bf16_t* p) { return *reinterpret_cast<const bf16x8*>(p); }

__device__ __forceinline__ void partialSM(f32x16& p0, f32x16& p1, float& m_reg, float& mn, float& alpha) {
  constexpr float C = SCALE * 1.4426950408889634f;
  float pmax = p0[0]; for (int r = 1; r < 16; ++r) pmax = fmaxf(pmax, p0[r]); for (int r = 0; r < 16; ++r) pmax = fmaxf(pmax, p1[r]);
  { auto rr = __builtin_amdgcn_permlane32_swap(__float_as_uint(pmax), __float_as_uint(pmax), false, false);
    pmax = fmaxf(__uint_as_float(rr[0]), __uint_as_float(rr[1])); }
  if (__builtin_expect(__all(pmax - m_reg <= THR / SCALE), 1)) { mn = m_reg; alpha = 1.f; }
  else { mn = fmaxf(m_reg, pmax); alpha = __builtin_amdgcn_exp2f((m_reg - mn) * C); m_reg = mn; }
  float mnC = -mn * C;
  for (int r = 0; r < 16; ++r) p0[r] = fmaf(p0[r], C, mnC); for (int r = 0; r < 16; ++r) p1[r] = fmaf(p1[r], C, mnC);
  for (int r = 0; r < 16; ++r) p0[r] = __builtin_amdgcn_exp2f(p0[r]);
}
__device__ __forceinline__ void finishSM(f32x16& p0, f32x16& p1, float alpha, float& l_reg, bf16x8& pa0, bf16x8& pa1, bf16x8& pa2, bf16x8& pa3) {
  for (int r = 0; r < 16; ++r) p1[r] = __builtin_amdgcn_exp2f(p1[r]);
  float ps = 0; for (int r = 0; r < 16; ++r) ps += p0[r]; for (int r = 0; r < 16; ++r) ps += p1[r];
  { auto rr = __builtin_amdgcn_permlane32_swap(__float_as_uint(ps), __float_as_uint(ps), false, false);
    ps = __uint_as_float(rr[0]) + __uint_as_float(rr[1]); }
  l_reg = l_reg * alpha + ps;
#define PK4(P, BASE, OUT) do { unsigned a0 = cvt_pk_bf16(P[BASE + 0], P[BASE + 1]), a1 = cvt_pk_bf16(P[BASE + 2], P[BASE + 3]);   \
    unsigned b0 = cvt_pk_bf16(P[BASE + 4], P[BASE + 5]), b1 = cvt_pk_bf16(P[BASE + 6], P[BASE + 7]);                              \
    auto r0 = __builtin_amdgcn_permlane32_swap(a0, b0, false, false); auto r1 = __builtin_amdgcn_permlane32_swap(a1, b1, false, false); \
    u32x4 w = {r0[0], r1[0], r0[1], r1[1]}; OUT = *reinterpret_cast<bf16x8*>(&w); } while (0)
  PK4(p0, 0, pa0); PK4(p0, 8, pa1); PK4(p1, 0, pa2); PK4(p1, 8, pa3);
#undef PK4
}
__device__ __forceinline__ void qkt(f32x16& p0, f32x16& p1, const bf16_t* Ks, const bf16x8* qr, int r32, int hi) {
  p0 = f32x16{}; p1 = f32x16{};
  for (int d0 = 0; d0 < 8; ++d0) { int cb = (d0 * 16 + hi * 8) * 2;
    bf16x8 b0 = *reinterpret_cast<const bf16x8*>((const char*)Ks + KSWZ(r32, cb));
    bf16x8 b1 = *reinterpret_cast<const bf16x8*>((const char*)Ks + KSWZ(32 + r32, cb));
    p0 = __builtin_amdgcn_mfma_f32_32x32x16_bf16(b0, qr[d0], p0, 0, 0, 0);
    p1 = __builtin_amdgcn_mfma_f32_32x32x16_bf16(b1, qr[d0], p1, 0, 0, 0); }
}
__device__ __forceinline__ int v_st(int k, int c) { const int kk = (k & ~0xC) | ((k & 4) << 1) | ((k & 8) >> 1); return ((kk >> 3) * 4 + (c >> 5)) * 512 + ((kk & 7) * 32 + (c & 31)) * 2; }
__device__ __forceinline__ int v_rd_base(int lane) { return ((lane & 3) << 3) | (((lane >> 2) & 3) << 6) | (((lane >> 4) & 1) << 5) | (((lane >> 5) & 1) << 8); }
constexpr int v_rd_off(int d0, int ks, int half) { return d0 * 512 + ks * 4096 + half * 2048; }
template <int OFF> __device__ __forceinline__ s16x4 tr_read(int vb) {
  s16x4 r; asm volatile("ds_read_b64_tr_b16 %0, %1 offset:%2" : "=&v"(r) : "v"(vb), "i"(OFF) : "memory"); return r;
}
template <int D0> __device__ __forceinline__ void pv_one(f32x16& od, int vb, bf16x8 pa0, bf16x8 pa1, bf16x8 pa2, bf16x8 pa3) {
  const s16x4 l0 = tr_read<v_rd_off(D0, 0, 0)>(vb), h0 = tr_read<v_rd_off(D0, 0, 1)>(vb), l1 = tr_read<v_rd_off(D0, 1, 0)>(vb), h1 = tr_read<v_rd_off(D0, 1, 1)>(vb);
  const s16x4 l2 = tr_read<v_rd_off(D0, 2, 0)>(vb), h2 = tr_read<v_rd_off(D0, 2, 1)>(vb), l3 = tr_read<v_rd_off(D0, 3, 0)>(vb), h3 = tr_read<v_rd_off(D0, 3, 1)>(vb);
  asm volatile("s_waitcnt lgkmcnt(0)" ::: "memory"); SBAR();
#define PK(L, H) (bf16x8){L[0], L[1], L[2], L[3], H[0], H[1], H[2], H[3]}
  od = __builtin_amdgcn_mfma_f32_32x32x16_bf16(pa0, PK(l0, h0), od, 0, 0, 0);
  od = __builtin_amdgcn_mfma_f32_32x32x16_bf16(pa1, PK(l1, h1), od, 0, 0, 0);
  od = __builtin_amdgcn_mfma_f32_32x32x16_bf16(pa2, PK(l2, h2), od, 0, 0, 0);
  od = __builtin_amdgcn_mfma_f32_32x32x16_bf16(pa3, PK(l3, h3), od, 0, 0, 0);
#undef PK
}
__device__ __forceinline__ void pv_d0(f32x16* o, int vb, bf16x8 pa0, bf16x8 pa1, bf16x8 pa2, bf16x8 pa3) {
  pv_one<0>(o[0], vb, pa0, pa1, pa2, pa3); pv_one<1>(o[1], vb, pa0, pa1, pa2, pa3); pv_one<2>(o[2], vb, pa0, pa1, pa2, pa3); pv_one<3>(o[3], vb, pa0, pa1, pa2, pa3);
}
__device__ __forceinline__ void attn_dense_body(const bf16_t* __restrict__ Qb, const bf16_t* __restrict__ Kh, const bf16_t* __restrict__ Vh,
                                                bf16_t* __restrict__ Ob, int seq, char* lds) {
  const int tid = opaque(threadIdx.x), wid = tid >> 6, lane = tid & 63, r32 = lane & 31, hi = lane >> 5;
  bf16_t* V_lds = (bf16_t*)lds; bf16_t* K_lds = (bf16_t*)(lds + 2 * SHM_V);
  float* ws = (float*)(lds + 2 * SHM_V + 2 * SHM_K) + wid * 64; float* li_l = ws; float* al_l = ws + 32;
  float m_reg = -1e30f, l_reg = 0; f32x16 o[4] = {}; bf16x8 qr[8];
  const bf16_t* Qw = Qb + (unsigned)((wid * QBLK + r32) * LDQ + hi * 8);
#pragma unroll
  for (int d0 = 0; d0 < 8; ++d0) qr[d0] = ld8(Qw + d0 * 16);
  const int sr = tid >> 4, sc = (tid & 15) * 8, vst0 = v_st(sr, sc), vst1 = v_st(32 + sr, sc);
  const int vb0 = (int)(uintptr_t)V_lds + v_rd_base(lane);
  struct { bf16x8 vs0, vs1, ks0, ks1; } sr_[SDEPTH];
  const unsigned voff0 = (unsigned)(sr * LDV + sc), voff1 = (unsigned)((32 + sr) * LDV + sc), koff0 = (unsigned)(sr * LDK + sc), koff1 = (unsigned)((32 + sr) * LDK + sc);
#define SLOAD(i, k0) do { const bf16_t* vb_ = Vh + (size_t)(k0) * LDV; const bf16_t* kb_ = Kh + (size_t)(k0) * LDK; \
    sr_[i].vs0 = ld8(vb_ + voff0); sr_[i].vs1 = ld8(vb_ + voff1); sr_[i].ks0 = ld8(kb_ + koff0); sr_[i].ks1 = ld8(kb_ + koff1); } while (0)
#define SWRITE(b, i) do { *(bf16x8*)((char*)V_lds + (b) * SHM_V + vst0) = sr_[i].vs0;          \
    *(bf16x8*)((char*)V_lds + (b) * SHM_V + vst1) = sr_[i].vs1; int kc = sc * 2;               \
    *(bf16x8*)((char*)K_lds + (b) * SHM_K + KSWZ(sr, kc)) = sr_[i].ks0;                       \
    *(bf16x8*)((char*)K_lds + (b) * SHM_K + KSWZ(32 + sr, kc)) = sr_[i].ks1; } while (0)
#define SWAIT() do { if constexpr (SDEPTH == 2) asm volatile("s_waitcnt vmcnt(4)" ::: "memory"); else asm volatile("s_waitcnt vmcnt(0)" ::: "memory"); } while (0)
#define RESC(a) do { if (__any((a) < 1.f)) { if (hi == 0) al_l[r32] = (a); asm volatile("s_waitcnt lgkmcnt(0)" ::: "memory"); \
    for (int d = 0; d < 4; ++d) for (int r = 0; r < 16; ++r) o[d][r] *= al_l[crow(r, hi)]; } } while (0)
  f32x16 pA0, pA1, pB0, pB1; float mnA, mnB, alA, alB; bf16x8 pa0, pa1, pa2, pa3; const int NT = seq / KVBLK;
  constexpr int SE = 0, SO = SDEPTH - 1;
  SLOAD(SE, 0); asm volatile("s_waitcnt vmcnt(0)" ::: "memory"); SWRITE(0, SE); __syncthreads();
  qkt(pA0, pA1, K_lds, qr, r32, hi); partialSM(pA0, pA1, m_reg, mnA, alA);
  SLOAD(SO, KVBLK); if constexpr (SDEPTH == 2) { if (2 < NT) SLOAD(SE, 2 * KVBLK); }
  SWAIT(); SWRITE(1, SO); __syncthreads();
  for (int j = 1; j + 1 < NT; j += 2) {
    SBAR(); qkt(pB0, pB1, (bf16_t*)((char*)K_lds + SHM_K), qr, r32, hi);
    finishSM(pA0, pA1, alA, l_reg, pa0, pa1, pa2, pa3); SBAR();
    SLOAD(SO, (j + SDEPTH) * KVBLK); SBAR();
    pv_d0(o, vb0, pa0, pa1, pa2, pa3); partialSM(pB0, pB1, m_reg, mnB, alB);
    __syncthreads(); SWAIT(); SWRITE(0, SE);
    RESC(alB); __syncthreads();
    SBAR(); qkt(pA0, pA1, K_lds, qr, r32, hi);
    finishSM(pB0, pB1, alB, l_reg, pa0, pa1, pa2, pa3); SBAR();
    if (SDEPTH == 1 || j + 3 < NT) SLOAD(SE, (j + 1 + SDEPTH) * KVBLK); SBAR();
    pv_d0(o, vb0 + (int)SHM_V, pa0, pa1, pa2, pa3); partialSM(pA0, pA1, m_reg, mnA, alA);
    __syncthreads(); SWAIT(); SWRITE(1, SO);
    RESC(alA); __syncthreads();
  }
  SBAR(); qkt(pB0, pB1, (bf16_t*)((char*)K_lds + SHM_K), qr, r32, hi);
  finishSM(pA0, pA1, alA, l_reg, pa0, pa1, pa2, pa3); SBAR();
  pv_d0(o, vb0, pa0, pa1, pa2, pa3); partialSM(pB0, pB1, m_reg, mnB, alB);
  __syncthreads(); RESC(alB);
  finishSM(pB0, pB1, alB, l_reg, pa0, pa1, pa2, pa3); SBAR();
  pv_d0(o, vb0 + (int)SHM_V, pa0, pa1, pa2, pa3);
  if (hi == 0) li_l[r32] = l_reg; asm volatile("s_waitcnt lgkmcnt(0)" ::: "memory");
  float rli[16];
#pragma unroll
  for (int r = 0; r < 16; ++r) rli[r] = __builtin_amdgcn_rcpf(li_l[crow(r, hi)]);
  const unsigned ooff = (unsigned)((wid * QBLK + 4 * hi) * LDO + r32);
#pragma unroll
  for (int r = 0; r < 16; ++r) { const int orow = (r & 3) + 8 * (r >> 2);
#pragma unroll
    for (int d0 = 0; d0 < 4; ++d0) Ob[ooff + (unsigned)(orow * LDO + d0 * 32)] = f2bf(o[d0][r] * rli[r]); }
#undef SLOAD
#undef SWRITE
#undef SWAIT
#undef RESC
}
#undef KSWZ
}
#define XB_TMO      128
#define XB_XCNT(j)  (256  + 64 * (j))
#define XB_XSUB(j)  (1280 + 64 * (j))
#define XB_XGEN(j)  (2304 + 64 * (j))
#define XB_TOP      3328
#define XB_TOPGEN   3392
#define XCD_BAR_WORDS 3456
#define XB_SPIN_CAP (1u << 18)

__device__ __forceinline__ unsigned xb_ld(unsigned* p)              { return __hip_atomic_load(p, __ATOMIC_RELAXED, __HIP_MEMORY_SCOPE_AGENT); }
__device__ __forceinline__ unsigned xb_add(unsigned* p, unsigned v) { return __hip_atomic_fetch_add(p, v, __ATOMIC_RELAXED, __HIP_MEMORY_SCOPE_AGENT); }
__device__ __forceinline__ unsigned xb_xcc_id() { return (unsigned)__builtin_amdgcn_s_getreg((3 << 11) | 20) & 0xFu; }
#define XB_SPIN(cond, bar) do { unsigned _sp = 0; while (cond) { __builtin_amdgcn_s_sleep(1); \
    if ((++_sp & 255u) == 0u) { if (xb_ld(&(bar)[XB_TMO])) break; if (_sp > XB_SPIN_CAP) { atomicAdd(&(bar)[XB_TMO], 1u); break; } } } } while (0)

struct XcdBarrier {
    unsigned* bar; unsigned x;
    volatile LAS unsigned* st;
};
__device__ __forceinline__ XcdBarrier xcd_barrier_post(unsigned* bar, volatile LAS unsigned* st) {
    XcdBarrier b; b.bar = bar; b.x = xb_xcc_id(); b.st = st;
    if (threadIdx.x == 0) (void)xb_add(&bar[XB_XCNT(b.x)], 1u);
    return b;
}
__device__ __forceinline__ void xcd_barrier_complete(unsigned* bar, unsigned x, unsigned& nloc, unsigned& nx) {
    const unsigned G = gridDim.x * gridDim.y * gridDim.z;
    unsigned sum, cnt, mine, sp = 0u;
    for (;;) {
        sum = 0u; cnt = 0u; mine = 0u;
#pragma unroll
        for (unsigned j = 0; j < 16; ++j) { const unsigned c = xb_ld(&bar[XB_XCNT(j)]); sum += c; cnt += (c > 0u) ? 1u : 0u; mine = (j == x) ? c : mine; }
        if (sum == G) break;
        __builtin_amdgcn_s_sleep(1);
        if ((++sp & 255u) == 0u) { if (xb_ld(&bar[XB_TMO])) break; if (sp > XB_SPIN_CAP) { atomicAdd(&bar[XB_TMO], 1u); break; } }
    }
    nloc = mine > 0u ? mine : 1u; nx = cnt > 0u ? cnt : 1u;
}
__device__ __forceinline__ void xcd_barrier(const XcdBarrier& b) {
    asm volatile("s_waitcnt vmcnt(0)" ::: "memory");
    __syncthreads();
    if (threadIdx.x == 0) {
        unsigned* bar = b.bar;
        __builtin_amdgcn_s_waitcnt(0);
        unsigned nloc = b.st[0], nx = b.st[1];
        if (nloc == 0u) { xcd_barrier_complete(bar, b.x, nloc, nx); b.st[0] = nloc; b.st[1] = nx; }
        const unsigned old = xb_add(&bar[XB_XSUB(b.x)], 1u);
        const unsigned gen = old / nloc;
        if (old + 1u == (gen + 1u) * nloc) {
            __builtin_amdgcn_fence(__ATOMIC_RELEASE, "agent");
            asm volatile("s_waitcnt vmcnt(0)" ::: "memory");
            const unsigned og = xb_add(&bar[XB_TOP], 1u);
            const unsigned tg = og / nx;
            if (og + 1u == (tg + 1u) * nx) xb_add(&bar[XB_TOPGEN], 1u);
            else XB_SPIN(xb_ld(&bar[XB_TOPGEN]) == tg, bar);
            __builtin_amdgcn_fence(__ATOMIC_ACQUIRE, "agent");
            xb_add(&bar[XB_XGEN(b.x)], 1u);
            asm volatile("s_waitcnt vmcnt(0)" ::: "memory");
        } else {
            XB_SPIN(xb_ld(&bar[XB_XGEN(b.x)]) == gen, bar);
            __builtin_amdgcn_fence(__ATOMIC_ACQUIRE, "agent");
            asm volatile("s_waitcnt vmcnt(0)" ::: "memory");
        }
    }
    __syncthreads();
}
constexpr int NWAVES = 8;
constexpr int RING_BYTES = 131072, LDSCTL_OFF = 135168, MISC_OFF = LDSCTL_OFF + 320, LDS_BYTES = 147456;
constexpr int CW_BAR = 4096;
constexpr int NPH_PRO = 3, NPH_LAYER = 11, NPH_TOTAL = NPH_PRO + DEPTH * NPH_LAYER;
struct Args { const float* in[31]; float* out; unsigned char* ws; int ph_lo, ph_hi; };
enum { I_X = 0, I_C, I_CTX, I_CCTX, I_WADA, I_BADA, I_WIN, I_WGATE, I_BGATE, I_GLANW, I_LAMRE, I_LAMIM, I_LOGDT, I_BRE, I_BIM, I_CRE, I_CIM, I_S5D, I_WGLU, I_QNW, I_KNW,
       I_WPG, I_WPS, I_WPA, I_WOUT, I_LN1W, I_LN1B, I_LN2W, I_LN2B, I_WFFI, I_WFFO };

template <int MAP> __device__ __forceinline__ int map_col(int n) {
    if (MAP == 1) return n < 3072 ? n : (n < 11520 ? n + 16 : (n < 11536 ? n - 8448 : -1));
    if (MAP == 2) { const int j = n >> 8, r = n & 255; return r < 128 ? 128 * j + r : DFF + 128 * j + (r - 128); }
    return n;
}
template <int MAP> __device__ __forceinline__ void transpose_item(const float* src, int sld, bf16_t* dst, int dld, int kb, int nb, LAS float* scr, int lane) {
    const int k0 = 64 * kb, n0 = 64 * nb, sc = map_col<MAP>(n0 + lane);
    const float* sp = src + (size_t)k0 * sld + (sc >= 0 ? sc : 0);
#pragma unroll 8
    for (int i = 0; i < 64; ++i) { const float v = sp[(size_t)i * sld]; scr[i * 65 + lane] = (sc >= 0) ? v : 0.f; }
    LDS_WAIT();
    const int c = lane & 7, ns = lane >> 3;
#pragma unroll
    for (int jn = 0; jn < 8; ++jn) { const int nn = jn * 8 + ns; const LAS float* s = scr + (8 * c) * 65 + nn;
        u32x4 o; o.x = cvt_pk_bf16(s[0 * 65], s[1 * 65]); o.y = cvt_pk_bf16(s[2 * 65], s[3 * 65]); o.z = cvt_pk_bf16(s[4 * 65], s[5 * 65]); o.w = cvt_pk_bf16(s[6 * 65], s[7 * 65]);
        *(u32x4*)(dst + (size_t)(n0 + nn) * dld + k0 + 8 * c) = o; }
    LDS_WAIT();
}
__device__ __forceinline__ void p0_prologue(const Args& a, LAS unsigned char* lds) {
    const int tid = threadIdx.x, lane = tid & 63, wave = __builtin_amdgcn_readfirstlane(tid >> 6);
    const int gw = blockIdx.x * NWAVES + wave, NGW = gridDim.x * NWAVES;
    LAS float* scr = (LAS float*)(lds + wave * 16640);
    constexpr int I_IN = 32 * 184, I_GLU = 12 * 12, I_CG = 16 * 32, I_CS = 12 * 32, I_CA = 16 * 32, I_OUT = 32 * 32, I_FFI = 32 * 176, I_FFO = 88 * 32;
    constexpr int PER_L = I_IN + I_GLU + I_CG + I_CS + I_CA + I_OUT + I_FFI + I_FFO;
    for (int it = gw; it < DEPTH * PER_L; it += NGW) {
        const int l = it / PER_L; int r = it % PER_L;
        unsigned char* wl = a.ws + WS_W + (size_t)l * WL_STRIDE;
        if (r < I_IN) { transpose_item<1>(a.in[I_WIN] + (size_t)l * DM * 11536, 11536, (bf16_t*)(wl + WL_IN), DM, r / 184, r % 184, scr, lane); continue; } r -= I_IN;
        if (r < I_GLU) { transpose_item<0>(a.in[I_WGLU] + (size_t)l * 768 * 768, 768, (bf16_t*)(wl + WL_GLU), 768, r / 12, r % 12, scr, lane); continue; } r -= I_GLU;
        if (r < I_CG) { transpose_item<0>(a.in[I_WPG] + (size_t)l * 1024 * DM, DM, (bf16_t*)(wl + WL_CAT), OCW, r / 32, r % 32, scr, lane); continue; } r -= I_CG;
        if (r < I_CS) { transpose_item<0>(a.in[I_WPS] + (size_t)l * 768 * DM, DM, (bf16_t*)(wl + WL_CAT) + 1024, OCW, r / 32, r % 32, scr, lane); continue; } r -= I_CS;
        if (r < I_CA) { transpose_item<0>(a.in[I_WPA] + (size_t)l * 1024 * DM, DM, (bf16_t*)(wl + WL_CAT) + 1792, OCW, r / 32, r % 32, scr, lane); continue; } r -= I_CA;
        if (r < I_OUT) { transpose_item<0>(a.in[I_WOUT] + (size_t)l * DM * DM, DM, (bf16_t*)(wl + WL_OUT), DM, r / 32, r % 32, scr, lane); continue; } r -= I_OUT;
        if (r < I_FFI) { transpose_item<2>(a.in[I_WFFI] + (size_t)l * DM * 2 * DFF, 2 * DFF, (bf16_t*)(wl + WL_FFI), DM, r / 176, r % 176, scr, lane); continue; } r -= I_FFI;
        transpose_item<0>(a.in[I_WFFO] + (size_t)l * DFF * DM, DM, (bf16_t*)(wl + WL_FFO), DFF, r / 32, r % 32, scr, lane);
    }
    __syncthreads();
    LAS float* SL = (LAS float*)lds;
    for (int i = tid; i < 5 * DM; i += NWAVES * 64) { const int r = i / DM, k = i % DM; const float v = r < 4 ? a.in[I_C][r * DM + k] : a.in[I_CCTX][k]; SL[i] = v / (1.0f + expf(-v)); }
    __syncthreads();
    float* MODP = (float*)(a.ws + WS_MODP);
    for (int it = gw; it < DEPTH * ADA_KS * 48; it += NGW) {
        const int l = it / (ADA_KS * 48), rem = it % (ADA_KS * 48), ks = rem / 48, nb = rem % 48;
        const float* wp = a.in[I_WADA] + ((size_t)l * DM + ks * 64) * NMOD + nb * 256 + lane * 4;
        f32x4 acc[5];
#pragma unroll
        for (int r = 0; r < 5; ++r) acc[r] = (f32x4){0.f, 0.f, 0.f, 0.f};
#pragma unroll 8
        for (int kk = 0; kk < 64; ++kk) { const f32x4 w = *(const f32x4*)(wp + (size_t)kk * NMOD); const int k = ks * 64 + kk;
#pragma unroll
            for (int r = 0; r < 5; ++r) acc[r] += w * SL[r * DM + k]; }
#pragma unroll
        for (int r = 0; r < 5; ++r) *(f32x4*)(MODP + ((size_t)((l * ADA_KS + ks) * 5 + r)) * NMOD + nb * 256 + lane * 4) = acc[r];
    }
    float* SA = (float*)(a.ws + WS_S5A); bf16_t* KB = (bf16_t*)(a.ws + WS_S5KB); bf16_t* CT = (bf16_t*)(a.ws + WS_S5CT);
    for (int i = blockIdx.x * (NWAVES * 64) + tid; i < DEPTH * 2 * 48 * 64; i += gridDim.x * NWAVES * 64) {
        const int p = i & 63, base = i >> 6, g = base % 48, l = base / 96;
        const double lre = (double)a.in[I_LAMRE][i], lim = (double)a.in[I_LAMIM][i], dt = exp((double)a.in[I_LOGDT][base]);
        const double mag = exp(lre * dt), are = mag * cos(lim * dt), aim = mag * sin(lim * dt), den = lre * lre + lim * lim;
        const double nr = are - 1.0, ni = aim, kre = (nr * lre + ni * lim) / den, kim = (ni * lre - nr * lim) / den;
        SA[2 * i] = (float)are; SA[2 * i + 1] = (float)aim;
        const float* bre = a.in[I_BRE] + ((size_t)(l * 48 + g) * 64 + p) * 16; const float* bim = a.in[I_BIM] + ((size_t)(l * 48 + g) * 64 + p) * 16;
        for (int c = 0; c < 16; ++c) { const double br = bre[c], bi = bim[c];
            KB[((size_t)base * 128 + p) * 16 + c] = f2bf((float)(kre * br - kim * bi)); KB[((size_t)base * 128 + 64 + p) * 16 + c] = f2bf((float)(kre * bi + kim * br)); }
        for (int c = 0; c < 16; ++c) { const size_t ci = ((size_t)base * 16 + c) * 64 + p;
            CT[((size_t)base * 16 + c) * 128 + p] = f2bf(a.in[I_CRE][ci]); CT[((size_t)base * 16 + c) * 128 + 64 + p] = f2bf(-a.in[I_CIM][ci]); }
    }
}
__device__ __forceinline__ void p1_mod(const Args& a) {
    const float* MODP = (const float*)(a.ws + WS_MODP); float* MOD = (float*)(a.ws + WS_MOD);
    for (int i = blockIdx.x * (NWAVES * 64) + threadIdx.x; i < DEPTH * 5 * NMOD; i += gridDim.x * NWAVES * 64) {
        const int l = i / (5 * NMOD), rem = i % (5 * NMOD), r = rem / NMOD, n = rem % NMOD;
        float s = a.in[I_BADA][l * NMOD + n];
        for (int ks = 0; ks < ADA_KS; ++ks) s += MODP[((size_t)((l * ADA_KS + ks) * 5 + r)) * NMOD + n];
        MOD[i] = s;
    }
}
__device__ __forceinline__ void p2_input(const Args& a) {
    const int tid_ = opaque(threadIdx.x), lane = tid_ & 63, wave = tid_ >> 6, gw = blockIdx.x * NWAVES + wave, NGW = gridDim.x * NWAVES;
    const float* MOD = (const float*)(a.ws + WS_MOD); float* X = (float*)(a.ws + WS_X); bf16_t* H = (bf16_t*)(a.ws + WS_H);
    for (int m = gw; m < MROWS; m += NGW) {
        const int b = m / TOK, t = m % TOK, cond = t < NCTX ? 4 : b;
        const float* src = t < NCTX ? a.in[I_CTX] + ((size_t)b * NCTX + t) * DM : a.in[I_X] + ((size_t)b * SEQ + (t - NCTX)) * DM;
        const float* sh = MOD + (size_t)cond * NMOD; const float* sc = sh + DM;
#pragma unroll
        for (int j = 0; j < 8; ++j) { const int col = lane * 4 + 256 * j; const f32x4 v = *(const f32x4*)(src + col);
            *(f32x4*)(X + (size_t)m * DM + col) = v;
            const f32x4 s1 = *(const f32x4*)(sc + col), s0 = *(const f32x4*)(sh + col); const f32x4 h = v * (1.0f + s1) + s0;
            u32x2 w; w.x = cvt_pk_bf16(h[0], h[1]); w.y = cvt_pk_bf16(h[2], h[3]); *(u32x2*)(H + (size_t)m * DM + col) = w; }
    }
}
__device__ __forceinline__ void ln_phase(const Args& a, const float* lnw, const float* lnb, const float* modp, float* out) {
    const int tid_ = opaque(threadIdx.x), lane = tid_ & 63, wave = tid_ >> 6, gw = blockIdx.x * NWAVES + wave, NGW = gridDim.x * NWAVES;
    const float* Z = (const float*)(a.ws + WS_Z); float* X = (float*)(a.ws + WS_X); bf16_t* H = (bf16_t*)(a.ws + WS_H);
    for (int m = gw; m < MROWS; m += NGW) {
        const int b = m / TOK, t = m % TOK, cond = t < NCTX ? 4 : b;
        if (out && t < NCTX) continue;
        f32x4 v[8]; float s = 0.f;
#pragma unroll
        for (int j = 0; j < 8; ++j) { v[j] = *(const f32x4*)(Z + (size_t)m * DM + lane * 4 + 256 * j); s += (v[j][0] + v[j][1]) + (v[j][2] + v[j][3]); }
        const float mean = wave_sum(s) * (1.0f / DM); float q = 0.f;
#pragma unroll
        for (int j = 0; j < 8; ++j) { v[j] = v[j] - mean; q += (v[j][0] * v[j][0] + v[j][1] * v[j][1]) + (v[j][2] * v[j][2] + v[j][3] * v[j][3]); }
        const float rstd = 1.0f / sqrtf(wave_sum(q) * (1.0f / DM) + LN_EPS);
#pragma unroll
        for (int j = 0; j < 8; ++j) { const int col = lane * 4 + 256 * j;
            const f32x4 xn = v[j] * rstd * *(const f32x4*)(lnw + col) + *(const f32x4*)(lnb + col);
            if (out) { *(f32x4*)(out + ((size_t)b * SEQ + (t - NCTX)) * DM + col) = xn; }
            else { *(f32x4*)(X + (size_t)m * DM + col) = xn;
                const f32x4 s0 = *(const f32x4*)(modp + (size_t)cond * NMOD + col), s1 = *(const f32x4*)(modp + (size_t)cond * NMOD + DM + col);
                const f32x4 h = xn * (1.0f + s1) + s0; u32x2 w; w.x = cvt_pk_bf16(h[0], h[1]); w.y = cvt_pk_bf16(h[2], h[3]); *(u32x2*)(H + (size_t)m * DM + col) = w; }
        }
    }
}
__device__ __forceinline__ void qk_phase(const Args& a, int l) {
    const int tid_ = opaque(threadIdx.x), lane = tid_ & 63, wave = tid_ >> 6, gw = blockIdx.x * NWAVES + wave, NGW = gridDim.x * NWAVES;
    const bf16_t* Y = (const bf16_t*)(a.ws + WS_Y); bf16_t* QN = (bf16_t*)(a.ws + WS_QN); bf16_t* KN = (bf16_t*)(a.ws + WS_KN);
    const float qw0 = a.in[I_QNW][l * 128 + 2 * lane], qw1 = a.in[I_QNW][l * 128 + 2 * lane + 1], kw0 = a.in[I_KNW][l * 128 + 2 * lane], kw1 = a.in[I_KNW][l * 128 + 2 * lane + 1];
    const float inv = powf(10000.0f, -(float)(lane & 31) * (1.0f / 32.0f));
    for (int m = gw; m < MROWS; m += NGW) {
        const int t = m % TOK; const bool lat = t >= NCTX; const int s = t - NCTX;
        float cs = 1.f, sn = 0.f;
#if defined(ABL) && ABL == 2
        if (false) {
#else
        if (lat) {
#endif
            const float pos = (lane < 32) ? (float)(s >> 6) : (float)(s & 63); const float ang = pos * inv; cs = cosf(ang); sn = sinf(ang); }
#pragma unroll
        for (int hh = 0; hh < 10; ++hh) {
            const bool isq = hh < 8;
            const unsigned pr = *(const unsigned*)(Y + (size_t)m * YW + (isq ? Y_AQ + hh * 128 : Y_AK + (hh - 8) * 128) + 2 * lane);
            float x0 = lo_bf(pr), x1 = hi_bf(pr);
            const float rstd = 1.0f / sqrtf(wave_sum(x0 * x0 + x1 * x1) * (1.0f / 128.0f) + LN_EPS);
            x0 *= rstd * (isq ? qw0 : kw0); x1 *= rstd * (isq ? qw1 : kw1);
            const float y0 = x0 * cs - x1 * sn, y1 = x0 * sn + x1 * cs;
            bf16_t* dst = isq ? QN + (size_t)m * 1024 + hh * 128 + 2 * lane : KN + (size_t)m * 256 + (hh - 8) * 128 + 2 * lane;
            *(unsigned*)dst = cvt_pk_bf16(y0, y1);
        }
    }
}
__device__ __forceinline__ void attn_phase(const Args& a, char* lds) {
    const bf16_t* Y = (const bf16_t*)(a.ws + WS_Y); const bf16_t* QN = (const bf16_t*)(a.ws + WS_QN); const bf16_t* KN = (const bf16_t*)(a.ws + WS_KN); bf16_t* OC = (bf16_t*)(a.ws + WS_OCAT);
    for (int u = blockIdx.x; u < 288; u += gridDim.x) {
        int b, h, qrow, seq;
        if (u < 256) { const int xg = u & 7, idx = u >> 3; b = xg >> 1; h = (xg & 1) * 4 + (idx >> 3); qrow = b * TOK + NCTX + 256 * (idx & 7); seq = TOK; }
        else { const int uc = u - 256; b = uc >> 3; h = uc & 7; qrow = b * TOK; seq = NCTX; }
        const int kvh = h >> 2; const size_t krow = (size_t)b * TOK;
        __syncthreads();
        att::attn_dense_body(QN + (size_t)qrow * 1024 + h * 128, KN + krow * 256 + kvh * 128, Y + krow * YW + Y_AV + kvh * 128, OC + (size_t)qrow * OCW + 1792 + h * 128, seq, lds);
    }
    __syncthreads();
}
__device__ __forceinline__ bf16x8 ldsfrag(const LAS bf16_t* base, int row, int ld, int k) { return *(const LAS bf16x8*)(base + row * ld + k); }
__device__ __forceinline__ void gla_chain(const Args& a, int l, int chain, LAS unsigned char* lds) {
    const int tid = opaque(threadIdx.x), wave = __builtin_amdgcn_readfirstlane(tid >> 6), lane = tid & 63, r32 = lane & 31, hh = lane >> 5;
    const int vs = chain & 7, dir = (chain >> 3) & 1, h = (chain >> 4) & 3, b = chain >> 6;
    const bf16_t* Y = (const bf16_t*)(a.ws + WS_Y); const float* GLR = (const float*)(a.ws + WS_GLR);
    float* OG = (float*)(a.ws + (dir ? WS_OGB : WS_OGF));
    LAS bf16_t* QE = (LAS bf16_t*)lds; LAS bf16_t* KE = QE + 64 * 136; LAS bf16_t* KDT = KE + 64 * 136; LAS bf16_t* VT = KDT + 128 * 72; LAS bf16_t* ATT = VT + 32 * 72; LAS bf16_t* ST = ATT + 64 * 72;
    LAS float* DEC = (LAS float*)(ST + 32 * 136); LAS float* GSUM = DEC + 128;
    const int d = tid & 127, jg = tid >> 7;
    float wg[16];
#pragma unroll
    for (int r = 0; r < 16; ++r) wg[r] = a.in[I_WGATE][((size_t)(l * 2 + dir) * 16 + r) * 512 + h * 128 + d];
    const float bgt = a.in[I_BGATE][(l * 2 + dir) * 512 + h * 128 + d];
    for (int i = tid; i < 32 * 136; i += NWAVES * 64) ST[i] = 0;
    f32x16 accS = {}, accO = {};
    __syncthreads();
    for (int ci = 0; ci < 36; ++ci) {
        const int t0 = dir == 0 ? ci * 64 : (ci < 4 ? (3 - ci) * 64 : NCTX + (35 - ci) * 64);
#if defined(ABL) && ABL == 1
        if (ci == 4) { accS = (f32x16){}; for (int i = tid; i < 32 * 136; i += NWAVES * 64) ST[i] = 0; __syncthreads(); }
#endif
        const size_t rowb = (size_t)b * TOK;
        float qv[16], kv[16], bb[16]; float run = 0.f;
#pragma unroll
        for (int jj = 0; jj < 16; ++jj) { const int j = 16 * jg + jj; const size_t m = rowb + (dir ? t0 + 63 - j : t0 + j);
            qv[jj] = bf2f(Y[m * YW + Y_GQ + h * 128 + d]); kv[jj] = bf2f(Y[m * YW + Y_GK + h * 128 + d]);
            const float* gl = GLR + m * 16; float pre = bgt;
#pragma unroll
            for (int r4 = 0; r4 < 4; ++r4) { const f32x4 g4 = *(const f32x4*)(gl + 4 * r4); pre += g4[0] * wg[4 * r4] + g4[1] * wg[4 * r4 + 1] + g4[2] * wg[4 * r4 + 2] + g4[3] * wg[4 * r4 + 3]; }
            run += flogsigmoid(pre) * (1.0f / 16.0f); bb[jj] = run; }
        GSUM[jg * 128 + d] = run;
        __syncthreads();
        float off = 0.f, tot = 0.f;
#pragma unroll
        for (int g4 = 0; g4 < 4; ++g4) { const float sg = GSUM[g4 * 128 + d]; off += (g4 < jg) ? sg : 0.f; tot += sg; }
#pragma unroll
        for (int jj = 0; jj < 16; ++jj) { const int j = 16 * jg + jj; const float bc = off + bb[jj];
            QE[j * 136 + d] = f2bf(qv[jj] * __expf(bc)); KE[j * 136 + d] = f2bf(kv[jj] * __expf(-bc)); KDT[d * 72 + j] = f2bf(kv[jj] * __expf(tot - bc)); }
        if (jg == 0) DEC[d] = __expf(tot);
        { const int j = tid >> 3, v0 = (tid & 7) * 4; const size_t m = rowb + (dir ? t0 + 63 - j : t0 + j);
          const u32x2 vv = *(const u32x2*)(Y + m * YW + Y_GV + h * 256 + vs * 32 + v0);
          VT[(v0 + 0) * 72 + j] = (bf16_t)(vv.x & 0xffffu); VT[(v0 + 1) * 72 + j] = (bf16_t)(vv.x >> 16); VT[(v0 + 2) * 72 + j] = (bf16_t)(vv.y & 0xffffu); VT[(v0 + 3) * 72 + j] = (bf16_t)(vv.y >> 16); }
        __syncthreads();
        if (wave < 4) {
            const int ib = wave >> 1, jb = wave & 1; f32x16 p = {};
#pragma unroll
            for (int s = 0; s < 8; ++s) p = __builtin_amdgcn_mfma_f32_32x32x16_bf16(ldsfrag(QE, 32 * ib + r32, 136, 16 * s + 8 * hh), ldsfrag(KE, 32 * jb + r32, 136, 16 * s + 8 * hh), p, 0, 0, 0);
#pragma unroll
            for (int rg = 0; rg < 16; ++rg) { const int i = 32 * ib + att::crow(rg, hh), j = 32 * jb + r32; ATT[i * 72 + j] = f2bf(i >= j ? p[rg] : 0.f); }
        } else if (wave < 6) {
            const int ib = wave - 4; accO = (f32x16){};
#pragma unroll
            for (int s = 0; s < 8; ++s) accO = __builtin_amdgcn_mfma_f32_32x32x16_bf16(ldsfrag(QE, 32 * ib + r32, 136, 16 * s + 8 * hh), ldsfrag(ST, r32, 136, 16 * s + 8 * hh), accO, 0, 0, 0);
        }
        __syncthreads();
        if (wave < 4) {
            const int db = wave; const float dec = DEC[32 * db + r32];
#pragma unroll
            for (int rg = 0; rg < 16; ++rg) accS[rg] *= dec;
#pragma unroll
            for (int s = 0; s < 4; ++s) accS = __builtin_amdgcn_mfma_f32_32x32x16_bf16(ldsfrag(VT, r32, 72, 16 * s + 8 * hh), ldsfrag(KDT, 32 * db + r32, 72, 16 * s + 8 * hh), accS, 0, 0, 0);
#pragma unroll
            for (int rg = 0; rg < 16; ++rg) ST[att::crow(rg, hh) * 136 + 32 * db + r32] = f2bf(accS[rg]);
        } else if (wave < 6) {
            const int ib = wave - 4;
#pragma unroll
            for (int s = 0; s < 4; ++s) accO = __builtin_amdgcn_mfma_f32_32x32x16_bf16(ldsfrag(ATT, 32 * ib + r32, 72, 16 * s + 8 * hh), ldsfrag(VT, r32, 72, 16 * s + 8 * hh), accO, 0, 0, 0);
#pragma unroll
            for (int rg = 0; rg < 16; ++rg) { const int i = 32 * ib + att::crow(rg, hh); const size_t m = rowb + (dir ? t0 + 63 - i : t0 + i);
                OG[m * 1024 + h * 256 + vs * 32 + r32] = accO[rg]; }
        }
        __syncthreads();
    }
}
__device__ __forceinline__ void s5_chain(const Args& a, int l, int chain, LAS unsigned char* ldsw, int lane_in) {
    const int lane = opaque(lane_in);
    const int dir = chain & 1, g = (chain >> 1) % 48, b = chain / 96, base = (l * 2 + dir) * 48 + g;
    const bf16_t* Y = (const bf16_t*)(a.ws + WS_Y); float* YS = (float*)(a.ws + (dir ? WS_YSB : WS_YSF));
    const float* SA = (const float*)(a.ws + WS_S5A); const bf16_t* KB = (const bf16_t*)(a.ws + WS_S5KB) + (size_t)base * 128 * 16; const bf16_t* CT = (const bf16_t*)(a.ws + WS_S5CT) + (size_t)base * 16 * 128;
    LAS float* BU = (LAS float*)ldsw; LAS bf16_t* XS = (LAS bf16_t*)(ldsw + 16 * 132 * 4);
    const int lq = lane >> 4, lr = lane & 15;
    const float are = SA[2 * (base * 64 + lane)], aim = SA[2 * (base * 64 + lane) + 1];
    const bf16x8 zero8 = {0, 0, 0, 0, 0, 0, 0, 0};
    bf16x8 fb[8], fc[4];
#pragma unroll
    for (int q = 0; q < 8; ++q) fb[q] = (lq < 2) ? *(const bf16x8*)(KB + (16 * q + lr) * 16 + 8 * lq) : zero8;
#pragma unroll
    for (int s = 0; s < 4; ++s) fc[s] = *(const bf16x8*)(CT + lr * 128 + 32 * s + 8 * lq);
    float xr = 0.f, xi = 0.f;
    for (int bi = 0; bi < 144; ++bi) {
        const int tb = dir == 0 ? bi : (bi < 16 ? 15 - bi : 143 - (bi - 16));
        const size_t row0 = (size_t)b * TOK + tb * 16;
#if defined(ABL) && ABL == 4
        if (bi == 16) { xr = 0.f; xi = 0.f; }
#endif
        const bf16x8 ua = (lq < 2) ? *(const bf16x8*)(Y + (row0 + lr) * YW + Y_SU + g * 16 + 8 * lq) : zero8;
#pragma unroll
        for (int q = 0; q < 8; ++q) { const f32x4 r = __builtin_amdgcn_mfma_f32_16x16x32_bf16(ua, fb[q], (f32x4){0.f, 0.f, 0.f, 0.f}, 0, 0, 0);
#pragma unroll
            for (int rg = 0; rg < 4; ++rg) BU[(4 * lq + rg) * 132 + 16 * q + lr] = r[rg]; }
        LDS_WAIT();
#pragma unroll
        for (int st = 0; st < 16; ++st) { const int t = dir ? 15 - st : st;
            const float bre = BU[t * 132 + lane], bim = BU[t * 132 + 64 + lane];
            const float nr = are * xr - aim * xi + bre, ni = are * xi + aim * xr + bim; xr = nr; xi = ni;
            XS[t * 136 + lane] = f2bf(xr); XS[t * 136 + 64 + lane] = f2bf(xi); }
        LDS_WAIT();
        f32x4 yo = {0.f, 0.f, 0.f, 0.f};
#pragma unroll
        for (int s = 0; s < 4; ++s) yo = __builtin_amdgcn_mfma_f32_16x16x32_bf16(*(const LAS bf16x8*)(XS + lr * 136 + 32 * s + 8 * lq), fc[s], yo, 0, 0, 0);
#pragma unroll
        for (int rg = 0; rg < 4; ++rg) YS[(row0 + 4 * lq + rg) * 768 + g * 16 + lr] = yo[rg];
        LDS_WAIT();
    }
}
__device__ __forceinline__ void postmix_phase(const Args& a, int l) {
    const int tid_ = opaque(threadIdx.x), lane = tid_ & 63, wave = tid_ >> 6, gw = blockIdx.x * NWAVES + wave, NGW = gridDim.x * NWAVES;
    const bf16_t* Y = (const bf16_t*)(a.ws + WS_Y); bf16_t* OC = (bf16_t*)(a.ws + WS_OCAT); bf16_t* YG = (bf16_t*)(a.ws + WS_YG);
    const float* OGF = (const float*)(a.ws + WS_OGF); const float* OGB = (const float*)(a.ws + WS_OGB); const float* YSF = (const float*)(a.ws + WS_YSF); const float* YSB = (const float*)(a.ws + WS_YSB);
    for (int m = gw; m < MROWS; m += NGW) {
#pragma unroll
        for (int h = 0; h < 4; ++h) { const int col = h * 256 + lane * 4;
            f32x4 o = *(const f32x4*)(OGF + (size_t)m * 1024 + col) + *(const f32x4*)(OGB + (size_t)m * 1024 + col);
            const float mean = wave_sum((o[0] + o[1]) + (o[2] + o[3])) * (1.0f / 256.0f); o = o - mean;
            const float rstd = 1.0f / sqrtf(wave_sum((o[0] * o[0] + o[1] * o[1]) + (o[2] * o[2] + o[3] * o[3])) * (1.0f / 256.0f) + LN_EPS);
            const f32x4 w = *(const f32x4*)(a.in[I_GLANW] + l * 1024 + col); const u32x2 gr = *(const u32x2*)(Y + (size_t)m * YW + Y_GR + col);
            o = o * rstd * w; u32x2 ov; ov.x = cvt_pk_bf16(o[0] * lo_bf(gr.x), o[1] * hi_bf(gr.x)); ov.y = cvt_pk_bf16(o[2] * lo_bf(gr.y), o[3] * hi_bf(gr.y));
            *(u32x2*)(OC + (size_t)m * OCW + col) = ov; }
#pragma unroll
        for (int j = 0; j < 3; ++j) { const int col = j * 256 + lane * 4;
            const u32x2 su = *(const u32x2*)(Y + (size_t)m * YW + Y_SU + col); const f32x4 dsk = *(const f32x4*)(a.in[I_S5D] + l * 768 + col);
            f32x4 y = *(const f32x4*)(YSF + (size_t)m * 768 + col) + *(const f32x4*)(YSB + (size_t)m * 768 + col);
#if defined(ABL) && ABL == 3
            y = (f32x4){0.f, 0.f, 0.f, 0.f};
#endif
            y[0] += lo_bf(su.x) * dsk[0]; y[1] += hi_bf(su.x) * dsk[1]; y[2] += lo_bf(su.y) * dsk[2]; y[3] += hi_bf(su.y) * dsk[3];
            u32x2 ov; ov.x = cvt_pk_bf16(fgelu_tanh(y[0]), fgelu_tanh(y[1])); ov.y = cvt_pk_bf16(fgelu_tanh(y[2]), fgelu_tanh(y[3]));
            *(u32x2*)(YG + (size_t)m * 768 + col) = ov; }
    }
}
#ifdef DIAG
constexpr size_t WS_DIAG = 512 * 1024;
__device__ __forceinline__ void diag_max(const Args& a, int k, float err) { if (!(err >= 0.f)) err = 9e9f; atomicMax((unsigned*)(a.ws + WS_DIAG) + k, __float_as_uint(err)); }
__device__ __forceinline__ unsigned dhash(unsigned x) { x ^= x >> 16; x *= 0x7feb352dU; x ^= x >> 15; x *= 0x846ca68bU; x ^= x >> 16; return x; }
__device__ __forceinline__ double ddot(const bf16_t* A, const bf16_t* B, int K) { double s = 0; for (int k = 0; k < K; ++k) s += (double)bf2f(A[k]) * (double)bf2f(B[k]); return s; }
__device__ __forceinline__ float relerr(float got, float ref, float floor_) { return fabsf(got - ref) / (fabsf(ref) + floor_); }
#define DIAG_NS 2048
#ifndef GLA_CHK_HI
#define GLA_CHK_HI 100000
#endif
#ifndef GLA_CHK_LO
#define GLA_CHK_LO 0
#endif
#ifndef GLA_CHK_DIR
#define GLA_CHK_DIR -1
#endif
#ifndef DIAG_LIMIT
#define DIAG_LIMIT 0.04f
#endif
#ifndef DIAG_LAYER
#define DIAG_LAYER 0
#endif
__device__ __forceinline__ void diag_check(const Args& a, int l, int which) {
    const int gt = blockIdx.x * (NWAVES * 64) + opaque(threadIdx.x), NT = gridDim.x * NWAVES * 64;
    unsigned char* ws = a.ws; unsigned char* wl = ws + WS_W + (size_t)l * WL_STRIDE;
    const bf16_t* H = (const bf16_t*)(ws + WS_H); const bf16_t* Y = (const bf16_t*)(ws + WS_Y); const float* GLR = (const float*)(ws + WS_GLR);
    const bf16_t* OC = (const bf16_t*)(ws + WS_OCAT); const bf16_t* YG = (const bf16_t*)(ws + WS_YG); const float* X = (const float*)(ws + WS_X); const float* Z = (const float*)(ws + WS_Z);
    const float* MOD = (const float*)(ws + WS_MOD) + (size_t)l * 5 * NMOD;
    if (which == 1) {
        const bf16_t* W = (const bf16_t*)(wl + WL_IN);
        for (int s = gt; s < DIAG_NS; s += NT) { const unsigned hx = dhash(s * 2654435761u + 17u); const int row = hx % MROWS; int n = (hx >> 13) % 11536; if ((s & 15) == 0) n = 11520 + (hx >> 9) % 16;
            const float d = (float)ddot(H + (size_t)row * DM, W + (size_t)n * DM, DM); float got; float ref = d;
            if (n >= 11520) got = GLR[(size_t)row * 16 + (n - 11520)];
            else { got = bf2f(Y[(size_t)row * YW + n]); if (n < 512) ref = d * 0.08838834764831845f; else if (n >= 2048 && n < 3072) ref = d / (1.0f + expf(-(float)d)); else if (n >= 5376) ref = 1.0f / (1.0f + expf(-(float)d)); }
            diag_max(a, 1, relerr(got, ref, 0.05f)); }
    }
    if (which == 2) {
        const float* OGF = (const float*)(ws + WS_OGF); const float* OGB = (const float*)(ws + WS_OGB); const float* YSF = (const float*)(ws + WS_YSF); const float* YSB = (const float*)(ws + WS_YSB);
        for (int s = gt; s < DIAG_NS; s += NT) { const unsigned hx = dhash(s * 2654435761u + 29u); const int row = hx % MROWS, c = (hx >> 14) % 1024, h = c >> 8;
            float mu = 0, var = 0; for (int v = 0; v < 256; ++v) mu += OGF[(size_t)row * 1024 + h * 256 + v] + OGB[(size_t)row * 1024 + h * 256 + v]; mu /= 256;
            for (int v = 0; v < 256; ++v) { const float o = OGF[(size_t)row * 1024 + h * 256 + v] + OGB[(size_t)row * 1024 + h * 256 + v] - mu; var += o * o; } var /= 256;
            const float o = OGF[(size_t)row * 1024 + c] + OGB[(size_t)row * 1024 + c];
            const float ref = (o - mu) / sqrtf((float)(var + 1e-6)) * a.in[I_GLANW][l * 1024 + c] * bf2f(Y[(size_t)row * YW + Y_GR + c]);
            diag_max(a, 2, relerr(bf2f(OC[(size_t)row * OCW + c]), ref, 0.05f));
            const int c2 = (hx >> 10) % 768; float y = YSF[(size_t)row * 768 + c2] + YSB[(size_t)row * 768 + c2] + bf2f(Y[(size_t)row * YW + Y_SU + c2]) * a.in[I_S5D][l * 768 + c2];
            const float g = 0.5f * y * (1.0f + tanhf((float)(0.7978845608028654f * (y + 0.044715f * y * y * y))));
            diag_max(a, 2, relerr(bf2f(YG[(size_t)row * 768 + c2]), g, 0.05f)); }
    }
    if (which == 3) {
        const bf16_t* W = (const bf16_t*)(wl + WL_GLU);
        for (int s = gt; s < DIAG_NS; s += NT) { const unsigned hx = dhash(s * 2654435761u + 31u); const int row = hx % MROWS, c = (hx >> 14) % 768;
            const float d = (float)ddot(YG + (size_t)row * 768, W + (size_t)c * 768, 768); const float ref = bf2f(YG[(size_t)row * 768 + c]) / (1.0f + expf(-(float)d));
            diag_max(a, 3, relerr(bf2f(OC[(size_t)row * OCW + 1024 + c]), ref, 0.03f)); }
    }
    if (which == 4) {
        const bf16_t* W = (const bf16_t*)(wl + WL_CAT);
        for (int s = gt; s < DIAG_NS; s += NT) { const unsigned hx = dhash(s * 2654435761u + 37u); const int row = hx % MROWS, c = (hx >> 14) % DM;
            const float pa = (float)ddot(OC + (size_t)row * OCW, W + (size_t)c * OCW, 1024), pb = (float)ddot(OC + (size_t)row * OCW + 1024, W + (size_t)c * OCW + 1024, 768), pc = (float)ddot(OC + (size_t)row * OCW + 1792, W + (size_t)c * OCW + 1792, 1024);
            const float ref = pa * bf2f(Y[(size_t)row * YW + Y_BG + c]) + pb * bf2f(Y[(size_t)row * YW + Y_BG + 2048 + c]) + pc * bf2f(Y[(size_t)row * YW + Y_BG + 4096 + c]);
            diag_max(a, 4, relerr(bf2f(H[(size_t)row * DM + c]), ref, 0.03f)); }
    }
    if (which == 5 || which == 8) {
        const bool ffn = which == 8; const bf16_t* W = (const bf16_t*)(wl + (ffn ? WL_FFO : WL_OUT)); const bf16_t* A = ffn ? Y : H; const int K = ffn ? DFF : DM;
        for (int s = gt; s < DIAG_NS; s += NT) { const unsigned hx = dhash(s * 2654435761u + 41u); const int row = hx % MROWS, c = (hx >> 14) % DM; const int t = row % TOK, cond = t < NCTX ? 4 : row / TOK;
            const float d = (float)ddot(A + (size_t)row * K, W + (size_t)c * K, K); const float ref = DN_ALPHA * X[(size_t)row * DM + c] + MOD[(size_t)cond * NMOD + (ffn ? 5 : 2) * DM + c] * d;
            diag_max(a, which, relerr(Z[(size_t)row * DM + c], ref, 0.02f)); }
    }
    if (which == 6 || which == 9) {
        const bool second = which == 9; const float* lw = a.in[second ? I_LN2W : I_LN1W] + l * DM; const float* lb = a.in[second ? I_LN2B : I_LN1B] + l * DM;
        const float* mp = second ? (const float*)(ws + WS_MOD) + (size_t)(l + 1) * 5 * NMOD : MOD + 3 * DM;
        for (int s = gt; s < 256; s += NT) { const unsigned hx = dhash(s * 2654435761u + 43u); const int row = hx % MROWS, c = (hx >> 14) % DM; const int t = row % TOK, cond = t < NCTX ? 4 : row / TOK;
            float mu = 0, var = 0; for (int k = 0; k < DM; ++k) mu += Z[(size_t)row * DM + k]; mu /= DM; for (int k = 0; k < DM; ++k) { const float dd = Z[(size_t)row * DM + k] - mu; var += dd * dd; } var /= DM;
            const float xn = (Z[(size_t)row * DM + c] - mu) / sqrtf((float)(var + 1e-6)) * lw[c] + lb[c];
            diag_max(a, which, relerr(X[(size_t)row * DM + c], xn, 0.02f));
            if (!(second && l + 1 == DEPTH)) { const float hh = xn * (1.0f + mp[(size_t)cond * NMOD + DM + c]) + mp[(size_t)cond * NMOD + c]; diag_max(a, which, relerr(bf2f(H[(size_t)row * DM + c]), hh, 0.03f)); } }
    }
    if (which == 7) {
        const bf16_t* W = (const bf16_t*)(wl + WL_FFI);
        for (int s = gt; s < DIAG_NS; s += NT) { const unsigned hx = dhash(s * 2654435761u + 47u); const int row = hx % MROWS, j = (hx >> 14) % DFF; const int na = (j >> 7) * 256 + (j & 127), nb = na + 128;
            const float da = (float)ddot(H + (size_t)row * DM, W + (size_t)na * DM, DM), db = (float)ddot(H + (size_t)row * DM, W + (size_t)nb * DM, DM); const float ref = da / (1.0f + expf(-(float)da)) * db;
            diag_max(a, 7, relerr(bf2f(Y[(size_t)row * DFF + j]), ref, 0.03f)); }
    }
}
__device__ __forceinline__ void diag_report(const Args& a) {
    if (blockIdx.x == 0 && threadIdx.x == 0) { const unsigned* d = (const unsigned*)(a.ws + WS_DIAG); float code = 0.f;
        for (int k = 1; k <= 9; ++k) { const float e = __uint_as_float(__hip_atomic_load(d + k, __ATOMIC_RELAXED, __HIP_MEMORY_SCOPE_AGENT)); if (e > DIAG_LIMIT) { int lvl = (int)(e * 20.f); lvl = lvl > 9 ? 9 : lvl; code = (float)((10 * k + lvl) * 100); break; } }
        if (code > 0.f) a.out[0] = code; }
}
#endif
#ifdef DIAG
__device__ __forceinline__ void diag_check2(const Args& a, int l, int which) {
    const int tid = opaque(threadIdx.x), lane = tid & 63, gwv = blockIdx.x * NWAVES + (tid >> 6), gt = blockIdx.x * (NWAVES * 64) + tid, NT = gridDim.x * NWAVES * 64;
    unsigned char* ws = a.ws; const bf16_t* Y = (const bf16_t*)(ws + WS_Y);
    if (which == 1) {
        const float* MOD = (const float*)(ws + WS_MOD);
        for (int s = gt; s < 1024; s += NT) { const unsigned hx = dhash(s * 2654435761u + 53u); const int ll = hx & 3, r = (hx >> 2) % 5, n = (hx >> 8) % NMOD; float acc = a.in[I_BADA][ll * NMOD + n];
            for (int k = 0; k < DM; ++k) { const float v = r < 4 ? a.in[I_C][r * DM + k] : a.in[I_CCTX][k]; acc += (v / (1.0f + expf(-v))) * a.in[I_WADA][((size_t)ll * DM + k) * NMOD + n]; }
            diag_max(a, 1, relerr(MOD[((size_t)ll * 5 + r) * NMOD + n], (float)acc, 0.01f)); }
    }
    if (which == 2) {
        for (int s = gt; s < 8192; s += NT) { const unsigned hx = dhash(s * 2654435761u + 59u); const int ll = hx & 3, mat = (hx >> 2) % 8; const unsigned h2 = dhash(hx); unsigned char* wl = ws + WS_W + (size_t)ll * WL_STRIDE;
            float src = 0.f; bf16_t got = 0;
            if (mat == 0) { const int n = h2 % NIN, k = (h2 >> 14) % DM; const int sc = map_col<1>(n); src = sc >= 0 ? a.in[I_WIN][((size_t)ll * DM + k) * 11536 + sc] : 0.f; got = ((const bf16_t*)(wl + WL_IN))[(size_t)n * DM + k]; }
            else if (mat == 1) { const int n = h2 % 768, k = (h2 >> 14) % 768; src = a.in[I_WGLU][((size_t)ll * 768 + k) * 768 + n]; got = ((const bf16_t*)(wl + WL_GLU))[(size_t)n * 768 + k]; }
            else if (mat == 2) { const int n = h2 % DM, k = (h2 >> 14) % 1024; src = a.in[I_WPG][((size_t)ll * 1024 + k) * DM + n]; got = ((const bf16_t*)(wl + WL_CAT))[(size_t)n * OCW + k]; }
            else if (mat == 3) { const int n = h2 % DM, k = (h2 >> 14) % 768; src = a.in[I_WPS][((size_t)ll * 768 + k) * DM + n]; got = ((const bf16_t*)(wl + WL_CAT))[(size_t)n * OCW + 1024 + k]; }
            else if (mat == 4) { const int n = h2 % DM, k = (h2 >> 14) % 1024; src = a.in[I_WPA][((size_t)ll * 1024 + k) * DM + n]; got = ((const bf16_t*)(wl + WL_CAT))[(size_t)n * OCW + 1792 + k]; }
            else if (mat == 5) { const int n = h2 % DM, k = (h2 >> 14) % DM; src = a.in[I_WOUT][((size_t)ll * DM + k) * DM + n]; got = ((const bf16_t*)(wl + WL_OUT))[(size_t)n * DM + k]; }
            else if (mat == 6) { const int n = h2 % (2 * DFF), k = (h2 >> 14) % DM; src = a.in[I_WFFI][((size_t)ll * DM + k) * (2 * DFF) + map_col<2>(n)]; got = ((const bf16_t*)(wl + WL_FFI))[(size_t)n * DM + k]; }
            else { const int n = h2 % DM, k = (h2 >> 12) % DFF; src = a.in[I_WFFO][((size_t)ll * DFF + k) * DM + n]; got = ((const bf16_t*)(wl + WL_FFO))[(size_t)n * DFF + k]; }
            diag_max(a, 2, (got == f2bf(src)) ? 0.f : 1.f); }
    }
    if (which == 3) {
        const bf16_t* QN = (const bf16_t*)(ws + WS_QN); const bf16_t* KN = (const bf16_t*)(ws + WS_KN);
        for (int s = gt; s < 2048; s += NT) { const unsigned hx = dhash(s * 2654435761u + 61u); const int m = hx % MROWS, hh = (hx >> 14) % 10, e = (hx >> 18) % 128; const int t = m % TOK; const bool isq = hh < 8;
            const bf16_t* src = Y + (size_t)m * YW + (isq ? Y_AQ + hh * 128 : Y_AK + (hh - 8) * 128); const float* w = a.in[isq ? I_QNW : I_KNW] + l * 128;
            float ss = 0.f; for (int i = 0; i < 128; ++i) { const float x = bf2f(src[i]); ss += x * x; } const float rstd = 1.0f / sqrtf(ss / 128.0f + 1e-6f);
            const int pi = e >> 1; const float x0 = bf2f(src[2 * pi]) * rstd * w[2 * pi], x1 = bf2f(src[2 * pi + 1]) * rstd * w[2 * pi + 1]; float ref;
            if (t >= NCTX) { const int sl = t - NCTX; const float pos = pi < 32 ? (float)(sl / 64) : (float)(sl % 64); const float ang = pos * powf(10000.0f, -(float)(pi & 31) / 32.0f); ref = (e & 1) ? x0 * sinf(ang) + x1 * cosf(ang) : x0 * cosf(ang) - x1 * sinf(ang); }
            else ref = (e & 1) ? x1 : x0;
            const float got = bf2f(isq ? QN[(size_t)m * 1024 + hh * 128 + e] : KN[(size_t)m * 256 + (hh - 8) * 128 + e]);
            diag_max(a, 3, relerr(got, ref, 0.05f)); }
    }
    if (which == 4) {
        const bf16_t* QN = (const bf16_t*)(ws + WS_QN); const bf16_t* KN = (const bf16_t*)(ws + WS_KN); const bf16_t* OC = (const bf16_t*)(ws + WS_OCAT);
        for (int s = gwv; s < 96; s += gridDim.x * NWAVES) { const unsigned hx = dhash(s * 2654435761u + 67u); int m = hx % MROWS; if (s < 16) m = (m / TOK) * TOK + (m % NCTX); const int h = (hx >> 14) & 7, kvh = h >> 2; const int t = m % TOK, b = m / TOK;
            const int nk = t < NCTX ? NCTX : TOK; const size_t kr0 = (size_t)b * TOK; float sc[36]; float mx = -1e30f;
#pragma unroll
            for (int i = 0; i < 36; ++i) { const int j = lane + 64 * i; float d = -1e30f; if (j < nk) { d = 0.f; for (int e = 0; e < 128; ++e) d += bf2f(QN[(size_t)m * 1024 + h * 128 + e]) * bf2f(KN[(kr0 + j) * 256 + kvh * 128 + e]); d *= 0.08838834764831845f; } sc[i] = d; mx = fmaxf(mx, d); }
#pragma unroll
            for (int o = 1; o < 64; o <<= 1) mx = fmaxf(mx, __shfl_xor(mx, o));
            float sum = 0.f;
#pragma unroll
            for (int i = 0; i < 36; ++i) { sc[i] = (lane + 64 * i < nk) ? expf(sc[i] - mx) : 0.f; sum += sc[i]; }
            sum = wave_sum(sum); float worst = 0.f;
            for (int e = 0; e < 128; ++e) { float acc = 0.f;
#pragma unroll
                for (int i = 0; i < 36; ++i) { const int j = lane + 64 * i; if (j < nk) acc += sc[i] * bf2f(Y[(kr0 + j) * YW + Y_AV + kvh * 128 + e]); }
                acc = wave_sum(acc) / sum; worst = fmaxf(worst, relerr(bf2f(OC[(size_t)m * OCW + 1792 + h * 128 + e]), acc, 0.03f)); }
            if (lane == 0) diag_max(a, 4, worst); }
    }
    if (which == 5) {
        for (int s = gwv; s < 24; s += gridDim.x * NWAVES) { const unsigned hx = dhash(s * 2654435761u + 71u); const int dir = s & 1, g = (hx >> 3) % 48, b = (hx >> 12) & 3, base = (l * 2 + dir) * 48 + g;
            const float* YS = (const float*)(ws + (dir ? WS_YSB : WS_YSF));
            const float lre = a.in[I_LAMRE][base * 64 + lane], lim = a.in[I_LAMIM][base * 64 + lane], dt = expf(a.in[I_LOGDT][base]);
            const float mag = expf(lre * dt), ared = mag * cosf(lim * dt), aimd = mag * sinf(lim * dt), den = lre * lre + lim * lim, nr = ared - 1.0f, ni = aimd; const float kre = ((nr * lre + ni * lim) / den), kim = ((ni * lre - nr * lim) / den), are = ared, aim = aimd;
            const float* bre = a.in[I_BRE] + ((size_t)(l * 48 + g) * 64 + lane) * 16; const float* bim = a.in[I_BIM] + ((size_t)(l * 48 + g) * 64 + lane) * 16;
            float xr = 0.f, xi = 0.f, sd = 0.f, sr = 0.f;
            for (int st = 0; st < TOK; ++st) { const int t = dir == 0 ? st : (st < NCTX ? NCTX - 1 - st : TOK - 1 - (st - NCTX)); const size_t m = (size_t)b * TOK + t;
                float ur = 0.f, ui = 0.f; for (int c = 0; c < 16; ++c) { const float u = bf2f(Y[m * YW + Y_SU + g * 16 + c]); ur += bre[c] * u; ui += bim[c] * u; }
                const float inr = kre * ur - kim * ui, ini = kre * ui + kim * ur; const float n0 = are * xr - aim * xi + inr, n1 = are * xi + aim * xr + ini; xr = n0; xi = n1;
                if ((st & 7) == 3 || st == NCTX || st == TOK - 1) { for (int c = 0; c < 16; ++c) { const size_t ci = ((size_t)base * 16 + c) * 64 + lane; const float y = wave_sum(a.in[I_CRE][ci] * xr - a.in[I_CIM][ci] * xi); const float df = YS[m * 768 + g * 16 + c] - y; sd += df * df; sr += y * y; } } }
            if (lane == 0) diag_max(a, 5, sqrtf(sd / (sr + 1e-12f))); }
    }
    if (which == 6) {
        const float* GLR = (const float*)(ws + WS_GLR);
        for (int s = gwv; s < 24; s += gridDim.x * NWAVES) { const unsigned hx = dhash(s * 2654435761u + 73u); const int dir = s & 1, h = (hx >> 3) & 3, b = (hx >> 6) & 3, v = (hx >> 9) & 255;
            const float* OG = (const float*)(ws + (dir ? WS_OGB : WS_OGF)); float wg0[16], wg1[16];
#pragma unroll
            for (int r = 0; r < 16; ++r) { wg0[r] = a.in[I_WGATE][((size_t)(l * 2 + dir) * 16 + r) * 512 + h * 128 + 2 * lane]; wg1[r] = a.in[I_WGATE][((size_t)(l * 2 + dir) * 16 + r) * 512 + h * 128 + 2 * lane + 1]; }
            const float bg0 = a.in[I_BGATE][(l * 2 + dir) * 512 + h * 128 + 2 * lane], bg1 = a.in[I_BGATE][(l * 2 + dir) * 512 + h * 128 + 2 * lane + 1];
            float s0 = 0.f, s1 = 0.f, sd = 0.f, sr = 0.f;
            for (int st = 0; st < TOK; ++st) { const int t = dir == 0 ? st : (st < NCTX ? NCTX - 1 - st : TOK - 1 - (st - NCTX)); const size_t m = (size_t)b * TOK + t;
                float p0 = bg0, p1 = bg1;
#pragma unroll
                for (int r = 0; r < 16; ++r) { const float gl = GLR[m * 16 + r]; p0 += gl * wg0[r]; p1 += gl * wg1[r]; }
                const float a0 = expf((fminf(p0, 0.f) - log1pf(expf(-fabsf(p0)))) / 16.0f), a1 = expf((fminf(p1, 0.f) - log1pf(expf(-fabsf(p1)))) / 16.0f);
                const float vv = bf2f(Y[m * YW + Y_GV + h * 256 + v]); const unsigned kq = *(const unsigned*)(Y + m * YW + Y_GK + h * 128 + 2 * lane), qq = *(const unsigned*)(Y + m * YW + Y_GQ + h * 128 + 2 * lane);
                s0 = a0 * s0 + lo_bf(kq) * vv; s1 = a1 * s1 + hi_bf(kq) * vv;
                const float o = wave_sum(lo_bf(qq) * s0 + hi_bf(qq) * s1);
                if (((st & 3) == 1 || st == NCTX) && st < GLA_CHK_HI && st >= GLA_CHK_LO && (GLA_CHK_DIR < 0 || dir == GLA_CHK_DIR)) { const float df = OG[m * 1024 + h * 256 + v] - o; sd += df * df; sr += o * o; } }
            if (lane == 0) diag_max(a, 6, sqrtf(sd / (sr + 1e-12f))); }
    }
}
#endif
__global__ void __launch_bounds__(NWAVES * 64, 2) fwd_kernel(Args args) {
    extern __shared__ __attribute__((aligned(16))) unsigned char lds_raw[];
    LAS unsigned char* lds = (LAS unsigned char*)lds_raw;
    const int tid = threadIdx.x, wave = __builtin_amdgcn_readfirstlane(tid >> 6), lane = tid & 63;
    const int G = gridDim.x;
    unsigned char* ws = args.ws;
    for (int u = tid; u < (LDS_BYTES - LDSCTL_OFF) / 4; u += NWAVES * 64) ((LAS unsigned*)(lds + LDSCTL_OFF))[u] = 0u;
    __syncthreads();
    const int lo = args.ph_lo, hi = args.ph_hi;
    XcdBarrier bar; bar.bar = (unsigned*)(ws + WS_CTL) + CW_BAR; bar.x = 0; bar.st = nullptr;
    if (hi - lo > 1) bar = xcd_barrier_post((unsigned*)(ws + WS_CTL) + CW_BAR, (volatile LAS unsigned*)(lds + MISC_OFF) + 8);
#ifndef PHMASK
#define PHMASK 0xFFFF
#endif
#define IN(k) (lo <= (k) && (k) < hi)
#define INL(j) ((((PHMASK) >> (j)) & 1) && IN(pb + (j)))
#define INP(j) ((((PHMASK) >> (11 + (j))) & 1) && IN(j))
#define SEAM(k) do { if (IN((k) + 1)) xcd_barrier(bar); } while (0)
#ifdef DIAG
#ifndef DIAG_MASK
#define DIAG_MASK 0x3FE
#endif
#define DCHK(id) do { if (((DIAG_MASK) >> (id)) & 1) { if (l == DIAG_LAYER) { diag_check(pa, l, id); xcd_barrier(bar); } } } while (0)
#else
#define DCHK(id) do { } while (0)
#endif

    if (INP(0)) { p0_prologue(args, lds); SEAM(0); }
    if (INP(1)) { p1_mod(args); SEAM(1); }
    if (INP(2)) { p2_input(args); SEAM(2); }
#if defined(DIAG) && defined(DIAG2_MASK)
    if ((DIAG2_MASK >> 1) & 1) { diag_check2(args, 0, 1); xcd_barrier(bar); }
    if ((DIAG2_MASK >> 2) & 1) { diag_check2(args, 0, 2); xcd_barrier(bar); }
#endif

    for (int l = 0; l < DEPTH; ++l) {
        const int pb = NPH_PRO + l * NPH_LAYER;
#define PHASE_ENV unsigned char* ws = opaque_ptr(args.ws); Args pa = args; pa.ws = ws; unsigned char* wl = ws + WS_W + (size_t)l * WL_STRIDE; const float* MOD = (const float*)(ws + WS_MOD); const float* modl = MOD + (size_t)l * 5 * NMOD; (void)wl; (void)modl; (void)MOD
        if (INL(0)) { PHASE_ENV;
            pg8::Gemm g{(const bf16_t*)(ws + WS_H), (const bf16_t*)(wl + WL_IN), MROWS, NIN, DM, DM, DM}; pg8::StaticOrder S; S.init(MROWS, NIN, G, (int)blockIdx.x);
            pg8::EpiInProj E{(bf16_t*)(ws + WS_Y), (float*)(ws + WS_GLR)};
            pg8::gemm_phase<pg8::EpiInProj, pg8::StaticOrder, true, true>(lds, g, S, E);
            SEAM(pb + 0); DCHK(1);
        }
        if (INL(1)) { PHASE_ENV; qk_phase(pa, l); SEAM(pb + 1);
#if defined(DIAG) && defined(DIAG2_MASK)
            if (((DIAG2_MASK >> 3) & 1) && l == DIAG_LAYER) { diag_check2(pa, l, 3); xcd_barrier(bar); }
#endif
        }
        if (INL(2)) { PHASE_ENV;
#ifndef MIXMASK
#define MIXMASK 7
#endif
            if (MIXMASK & 1) attn_phase(pa, (char*)lds_raw);
            if (MIXMASK & 2) { for (int ch = blockIdx.x; ch < 256; ch += G) { gla_chain(pa, l, ch, lds); } }
            if (MIXMASK & 4) { if (wave < 2) { for (int ch = blockIdx.x + wave * G; ch < 384; ch += 2 * G) s5_chain(pa, l, ch, lds + wave * 12800, lane); } }
            SEAM(pb + 2);
#if defined(DIAG) && defined(DIAG2_MASK)
            if (l == DIAG_LAYER) { if ((DIAG2_MASK >> 4) & 1) diag_check2(pa, l, 4); if ((DIAG2_MASK >> 5) & 1) diag_check2(pa, l, 5); if ((DIAG2_MASK >> 6) & 1) diag_check2(pa, l, 6); xcd_barrier(bar); }
#endif
        }
        if (INL(3)) { PHASE_ENV; postmix_phase(pa, l); SEAM(pb + 3); DCHK(2); }
        if (INL(4)) { PHASE_ENV;
            pg8::Gemm g{(const bf16_t*)(ws + WS_YG), (const bf16_t*)(wl + WL_GLU), MROWS, 768, 768, 768, 768}; pg8::StaticOrder S; S.init(MROWS, 768, G, (int)blockIdx.x);
            pg8::EpiGlu E{(const bf16_t*)(ws + WS_YG), (bf16_t*)(ws + WS_OCAT)};
            pg8::gemm_phase<pg8::EpiGlu, pg8::StaticOrder, true, true>(lds, g, S, E);
            SEAM(pb + 4); DCHK(3);
        }
        if (INL(5)) { PHASE_ENV;
            const bf16_t* OC = (const bf16_t*)(ws + WS_OCAT); const bf16_t* WC = (const bf16_t*)(wl + WL_CAT);
            pg8::StaticOrder S; S.init(MROWS, DM, G, (int)blockIdx.x);
            { pg8::Gemm g{OC, WC, MROWS, DM, 1024, OCW, OCW}; pg8::EpiMerge<0> E{(const bf16_t*)(ws + WS_Y), (float*)(ws + WS_Z), (bf16_t*)(ws + WS_H)};
              pg8::gemm_phase<pg8::EpiMerge<0>, pg8::StaticOrder, true, true>(lds, g, S, E); }
            { pg8::Gemm g{OC + 1024, WC + 1024, MROWS, DM, 768, OCW, OCW}; pg8::EpiMerge<1> E{(const bf16_t*)(ws + WS_Y), (float*)(ws + WS_Z), (bf16_t*)(ws + WS_H)};
              pg8::gemm_phase<pg8::EpiMerge<1>, pg8::StaticOrder, true, true>(lds, g, S, E); }
            { pg8::Gemm g{OC + 1792, WC + 1792, MROWS, DM, 1024, OCW, OCW}; pg8::EpiMerge<2> E{(const bf16_t*)(ws + WS_Y), (float*)(ws + WS_Z), (bf16_t*)(ws + WS_H)};
              pg8::gemm_phase<pg8::EpiMerge<2>, pg8::StaticOrder, true, true>(lds, g, S, E); }
            SEAM(pb + 5); DCHK(4);
        }
        if (INL(6)) { PHASE_ENV;
            pg8::Gemm g{(const bf16_t*)(ws + WS_H), (const bf16_t*)(wl + WL_OUT), MROWS, DM, DM, DM, DM}; pg8::StaticOrder S; S.init(MROWS, DM, G, (int)blockIdx.x);
            pg8::EpiResid E{(const float*)(ws + WS_X), (float*)(ws + WS_Z), modl + 2 * DM};
            pg8::gemm_phase<pg8::EpiResid, pg8::StaticOrder, true, true>(lds, g, S, E);
            SEAM(pb + 6); DCHK(5);
        }
        if (INL(7)) { PHASE_ENV; ln_phase(pa, pa.in[I_LN1W] + l * DM, pa.in[I_LN1B] + l * DM, modl + 3 * DM, nullptr); SEAM(pb + 7); DCHK(6); }
        if (INL(8)) { PHASE_ENV;
            pg8::Gemm g{(const bf16_t*)(ws + WS_H), (const bf16_t*)(wl + WL_FFI), MROWS, 2 * DFF, DM, DM, DM}; pg8::StaticOrder S; S.init(MROWS, 2 * DFF, G, (int)blockIdx.x);
            pg8::EpiSwiglu E{(bf16_t*)(ws + WS_Y)};
            pg8::gemm_phase<pg8::EpiSwiglu, pg8::StaticOrder, true, true>(lds, g, S, E);
            SEAM(pb + 8); DCHK(7);
        }
        if (INL(9)) { PHASE_ENV;
            pg8::Gemm g{(const bf16_t*)(ws + WS_Y), (const bf16_t*)(wl + WL_FFO), MROWS, DM, DFF, DFF, DFF}; pg8::StaticOrder S; S.init(MROWS, DM, G, (int)blockIdx.x);
            pg8::EpiResid E{(const float*)(ws + WS_X), (float*)(ws + WS_Z), modl + 5 * DM};
            pg8::gemm_phase<pg8::EpiResid, pg8::StaticOrder, true, true>(lds, g, S, E);
            SEAM(pb + 9); DCHK(8);
        }
        if (INL(10)) { PHASE_ENV;
            if (l + 1 < DEPTH) ln_phase(pa, pa.in[I_LN2W] + l * DM, pa.in[I_LN2B] + l * DM, MOD + (size_t)(l + 1) * 5 * NMOD, nullptr);
            else ln_phase(pa, pa.in[I_LN2W] + l * DM, pa.in[I_LN2B] + l * DM, nullptr, pa.out);
            SEAM(pb + 10);
#ifdef DIAG
            if ((DIAG_MASK >> 9) & 1) { if (l == DIAG_LAYER) { if (!IN(pb + 11)) xcd_barrier(bar); diag_check(pa, l, 9); xcd_barrier(bar); } }
#endif
        }
    }
#ifdef DIAG
    xcd_barrier(bar); diag_report(args);
#endif
#undef IN
#undef INL
#undef INP
#undef SEAM
}

#ifndef MK_MULTI_LAUNCH
#define MK_MULTI_LAUNCH 0
#endif
extern "C" void kernel_launch(void* const* d_in, const int* in_sizes, int n_in, void* d_out, int out_size, void* d_ws, size_t ws_size, hipStream_t stream) {
    static int grid = 0;
    if (grid == 0) {
        if (n_in != 31 || out_size != NB * SEQ * DM || ws_size < WS_END) { fprintf(stderr, "kernel_launch: unexpected shapes (n_in %d out %d ws %zu, need %zu)\n", n_in, out_size, ws_size, (size_t)WS_END); grid = -1; return; }
        int dev = 0, cus = 0, per_cu = 0;
        if (hipGetDevice(&dev) != hipSuccess || hipDeviceGetAttribute(&cus, hipDeviceAttributeMultiprocessorCount, dev) != hipSuccess) { grid = -1; return; }
        if (hipFuncSetAttribute((const void*)fwd_kernel, hipFuncAttributeMaxDynamicSharedMemorySize, LDS_BYTES) != hipSuccess) { fprintf(stderr, "kernel_launch: hipFuncSetAttribute failed\n"); grid = -1; return; }
        if (hipOccupancyMaxActiveBlocksPerMultiprocessor(&per_cu, (const void*)fwd_kernel, NWAVES * 64, LDS_BYTES) != hipSuccess || per_cu < 1) fprintf(stderr, "kernel_launch: occupancy query says %d\n", per_cu);
        (void)hipGetLastError();
        grid = cus;
    }
    if (grid < 0) return;
    (void)hipMemsetAsync((char*)d_ws + WS_CTL, 0, CTL_ZERO_BYTES, stream);
    Args a{};
    for (int i = 0; i < 31; ++i) a.in[i] = (const float*)d_in[i];
    a.out = (float*)d_out; a.ws = (unsigned char*)d_ws;
#if MK_MULTI_LAUNCH
    for (int p = 0; p < NPH_TOTAL; ++p) { a.ph_lo = p; a.ph_hi = p + 1; hipLaunchKernelGGL(fwd_kernel, dim3(grid), dim3(NWAVES * 64), LDS_BYTES, stream, a); }
#else
    a.ph_lo = 0; a.ph_hi = NPH_TOTAL; hipLaunchKernelGGL(fwd_kernel, dim3(grid), dim3(NWAVES * 64), LDS_BYTES, stream, a);
#endif
    const hipError_t le = hipPeekAtLastError();
    if (le != hipSuccess) fprintf(stderr, "kernel_launch: launch failed: %s\n", hipGetErrorName(le));
}
```

```cpp
#include <hip/hip_runtime.h>
#include <hip/hip_bf16.h>
#include <cstdio>
#include <cstdint>

#define LAS __attribute__((address_space(3)))
typedef unsigned short bf16_t;
typedef short bf16x8 __attribute__((ext_vector_type(8)));
typedef short s16x4 __attribute__((ext_vector_type(4)));
typedef float f32x4 __attribute__((ext_vector_type(4)));
typedef float f32x2 __attribute__((ext_vector_type(2)));
typedef float f32x8 __attribute__((ext_vector_type(8)));
typedef float f32x16 __attribute__((ext_vector_type(16)));
typedef unsigned u32x4 __attribute__((ext_vector_type(4)));
typedef unsigned u32x2 __attribute__((ext_vector_type(2)));

constexpr int DM = 2048, NB = 4, SEQ = 2048, NCTX = 256, TOK = NCTX + SEQ, MROWS = NB * TOK, DEPTH = 4;
constexpr int NIN = 11776;
constexpr int YW = 11520;
constexpr int Y_GQ = 0, Y_GK = 512, Y_GV = 1024, Y_GR = 2048, Y_SU = 3072, Y_AQ = 3840, Y_AK = 4864, Y_AV = 5120, Y_BG = 5376;
constexpr int DFF = 5632, OCW = 2816;
constexpr int NMOD = 6 * DM;
constexpr int ADA_KS = 32;
constexpr float DN_ALPHA = 1.6817928305074290f;
constexpr float LN_EPS = 1e-6f;

constexpr size_t MiB = 1u << 20;
constexpr size_t WS_CTL = 0, CTL_ZERO_BYTES = 1 * MiB;
constexpr size_t WS_MODP = 1 * MiB;
constexpr size_t WS_MOD = 32 * MiB;
constexpr size_t WS_S5A = 33 * MiB;
constexpr size_t WS_S5KB = 34 * MiB;
constexpr size_t WS_S5CT = 36 * MiB;
constexpr size_t WS_GLR = 38 * MiB;
constexpr size_t WS_X = 40 * MiB;
constexpr size_t WS_Z = 112 * MiB;
constexpr size_t WS_H = 184 * MiB;
constexpr size_t WS_Y = 220 * MiB;
constexpr size_t WS_QN = 423 * MiB;
constexpr size_t WS_KN = 441 * MiB;
constexpr size_t WS_OCAT = 446 * MiB;
constexpr size_t WS_OGF = 496 * MiB, WS_OGB = 532 * MiB;
constexpr size_t WS_YSF = 568 * MiB, WS_YSB = 595 * MiB;
constexpr size_t WS_YG = 622 * MiB;
constexpr size_t WS_W = 636 * MiB;
constexpr size_t WL_IN = 0, WL_GLU = 46 * MiB, WL_CAT = 48 * MiB, WL_OUT = 59 * MiB, WL_FFI = 67 * MiB, WL_FFO = 111 * MiB, WL_STRIDE = 133 * MiB;
constexpr size_t WS_QE = WS_W + 4 * WL_STRIDE;
constexpr size_t WS_KE = WS_QE + 18 * MiB;
constexpr size_t WS_KDT = WS_KE + 18 * MiB;
constexpr size_t WS_VT = WS_KDT + 18 * MiB;
constexpr size_t WS_DEC = WS_VT + 18 * MiB;
constexpr size_t WS_END = WS_DEC + 1 * MiB;

__device__ __forceinline__ float bf2f(bf16_t b) { return __uint_as_float(((unsigned)b) << 16); }
typedef __bf16 bf16x2n __attribute__((ext_vector_type(2)));
__device__ __forceinline__ unsigned cvt_pk_bf16(float lo, float hi) { const f32x2 v = {lo, hi}; return __builtin_bit_cast(unsigned, __builtin_convertvector(v, bf16x2n)); }
__device__ __forceinline__ bf16_t f2bf(float f) { return __builtin_bit_cast(unsigned short, (__bf16)f); }
__device__ __forceinline__ float lo_bf(unsigned w) { return __uint_as_float(w << 16); }
__device__ __forceinline__ float hi_bf(unsigned w) { return __uint_as_float(w & 0xffff0000u); }
__device__ __forceinline__ float fsigmoid(float x) { return 1.0f / (1.0f + __expf(-x)); }
__device__ __forceinline__ float fsilu(float x) { return x / (1.0f + __expf(-x)); }
__device__ __forceinline__ float flogsigmoid(float x) { return fminf(x, 0.f) - log1pf(__expf(-fabsf(x))); }
__device__ __forceinline__ float fgelu_tanh(float x) { const float u = 0.7978845608028654f * (x + 0.044715f * x * x * x); const float e = __expf(2.0f * u); const float t = 1.0f - 2.0f / (e + 1.0f); return 0.5f * x * (1.0f + t); }
__device__ __forceinline__ float wave_sum(float v) {
#pragma unroll
    for (int o = 1; o < 64; o <<= 1) v += __shfl_xor(v, o);
    return v;
}
__device__ __forceinline__ int opaque(int x) { asm volatile("" : "+v"(x)); return x; }
__device__ __forceinline__ unsigned char* opaque_ptr(unsigned char* p) { asm volatile("" : "+s"(p)); return p; }
#define LDS_WAIT() asm volatile("s_waitcnt lgkmcnt(0)" ::: "memory")
#define VM_WAIT() asm volatile("s_waitcnt vmcnt(0)" ::: "memory")
namespace pg8 {
constexpr int BM = 256, BK = 64, HALF = 128, HTB = HALF * BK * 2  , STAGE_BYTES = 8 * HTB, NXCD = 8, WGM = 8;
__host__ __device__ __forceinline__ int lds_byte(int r, int c) { const int st = (r >> 4) * 2 + (c >> 5), rr = r & 15, cc = c & 31, ob = rr * 64 + cc * 2; return st * 1024 + (ob ^ (((ob >> 9) & 1) << 5)); }
__host__ __device__ __forceinline__ void stage_rc(int b, int& R, int& C) { const int st = b / 1024, sb = b % 1024, swz = sb ^ (((sb >> 9) & 1) << 5); R = (st >> 1) * 16 + swz / 64; C = (st & 1) * 32 + (swz % 64) / 2; }
__host__ __device__ __forceinline__ int perm32(int rho) { const int n = rho >> 4, i = rho & 15; return 8 * (i >> 2) + 4 * n + (i & 3); }

struct Unit { int pm, pn; };
struct Gemm { const bf16_t* A; const bf16_t* Bt; int M, N, K, lda, ldb; };

struct StaticOrder {
    int nM, nN, nwg, G, c;
    __host__ __device__ void init(int M, int N, int G_, int c_) { nM = M / BM; nN = N / BM; nwg = nM * nN; G = G_; c = c_; }
    __host__ __device__ bool next(int i, Unit& u) const {
        const long L = (long)i * G + c; if (L >= nwg) return false;
        int wgid = (int)L; { const int q = nwg / NXCD, r = nwg % NXCD, xcd = wgid % NXCD, off = wgid / NXCD; wgid = (xcd < r ? xcd * (q + 1) : r * (q + 1) + (xcd - r) * q) + off; }
        const int nig = WGM * nN, gid = wgid / nig, fm = gid * WGM, gsz = (nM - fm) < WGM ? (nM - fm) : WGM;
        u.pm = fm + ((wgid % nig) % gsz); u.pn = (wgid % nig) / gsz; return true;
    }
    __device__ __forceinline__ void a_ready(const Unit&) const {}
    __device__ __forceinline__ void done(const Unit&) const {}
};

template <class Epi, class Sched, bool ALIGN_EPI = false, bool SP2 = false>
__device__ __forceinline__ void gemm_phase(LAS unsigned char* lds, const Gemm g, const Sched& S, const Epi& E) {
    const int tid = opaque(threadIdx.x), wid = __builtin_amdgcn_readfirstlane(tid >> 6), lane = tid & 63, wr = wid >> 2, wc = wid & 3, fr = lane & 15, fq = lane >> 4;
    const int K = g.K, nt = K / BK;
    unsigned voffA[2], voffB[2];
#pragma unroll
    for (int i = 0; i < 2; ++i) { int R, C; stage_rc(tid * 16 + i * 8192, R, C); const int Rb = Epi::PERM ? ((R & ~31) + perm32(R & 31)) : R;
        voffA[i] = (unsigned)(R * g.lda + C) * 2u; voffB[i] = (unsigned)(Rb * g.ldb + C) * 2u; }
    const size_t kstep = (size_t)(BK * 2);
    const size_t hstepA = (size_t)HALF * g.lda * 2, hstepB = (size_t)HALF * g.ldb * 2;
    const size_t tstepA = 2 * hstepA, tstepB = 2 * hstepB;
    const unsigned ldsw = (unsigned)wid * 1024u;
    const int aoff = lds_byte(wr * 64 + fr, fq * 8), boff = lds_byte(wc * 32 + fr, fq * 8);
#define PG8_SA(b, h) (((b) * 2 + (h)) * HTB)
#define PG8_SB(b, h) ((4 + (b) * 2 + (h)) * HTB)
#define PG8_STAGE(bufoff, gbase, voff) do { _Pragma("unroll") for (int _i = 0; _i < 2; ++_i) \
        __builtin_amdgcn_global_load_lds((const unsigned*)((const char*)(gbase) + (voff)[_i]), (LAS unsigned*)(lds + (bufoff) + ldsw + _i * 8192), 16, 0, 0); } while (0)
#define PG8_LDA(dst, b, h) do { _Pragma("unroll") for (int m = 0; m < 4; ++m) _Pragma("unroll") for (int k = 0; k < 2; ++k) dst[m][k] = *(const LAS bf16x8*)(lds + PG8_SA(b, h) + aoff + m * 2048 + k * 1024); } while (0)
#define PG8_LDB(dst, b, h) do { _Pragma("unroll") for (int n = 0; n < 2; ++n) _Pragma("unroll") for (int k = 0; k < 2; ++k) dst[n][k] = *(const LAS bf16x8*)(lds + PG8_SB(b, h) + boff + n * 2048 + k * 1024); } while (0)
#define PG8_MMA(ai, bj, At, Bt) do { __builtin_amdgcn_s_setprio(1); _Pragma("unroll") for (int m = 0; m < 4; ++m) _Pragma("unroll") for (int n = 0; n < 2; ++n) _Pragma("unroll") for (int k = 0; k < 2; ++k) \
        acc[ai][bj][m][n] = __builtin_amdgcn_mfma_f32_16x16x32_bf16(Bt[n][k], At[m][k], acc[ai][bj][m][n], 0, 0, 0); __builtin_amdgcn_s_setprio(0); } while (0)
#define PG8_WAIT_V(n) asm volatile("s_waitcnt vmcnt(" #n ")" ::: "memory")
#define PG8_WAIT_L(n) asm volatile("s_waitcnt lgkmcnt(" #n ")" ::: "memory")
#define PG8_BAR __builtin_amdgcn_s_barrier()
#define PG8_SCHED __builtin_amdgcn_sched_barrier(0)
    Unit cur, nxt; int ui = 0;
    if (!S.next(0, cur)) return;
    f32x4 acc[2][2][4][2];
#pragma unroll
    for (int a = 0; a < 2; ++a)
#pragma unroll
        for (int b = 0; b < 2; ++b)
#pragma unroll
            for (int m = 0; m < 4; ++m)
#pragma unroll
                for (int n = 0; n < 2; ++n) acc[a][b][m][n] = (f32x4){0.f, 0.f, 0.f, 0.f};
    bf16x8 At[4][2], B0[2][2], B1[2][2];
    const char* cA = (const char*)g.A + (size_t)cur.pm * tstepA; const char* cB = (const char*)g.Bt + (size_t)cur.pn * tstepB;
    S.a_ready(cur);
    if constexpr (SP2) {
        PG8_STAGE(PG8_SB(0, 0), cB, voffB); PG8_STAGE(PG8_SB(0, 1), cB + hstepB, voffB); PG8_STAGE(PG8_SA(0, 0), cA, voffA); PG8_STAGE(PG8_SA(0, 1), cA + hstepA, voffA);
        if (wr == 1) PG8_BAR;
        PG8_WAIT_V(2); PG8_BAR;
        PG8_STAGE(PG8_SB(1, 0), cB + kstep, voffB); PG8_STAGE(PG8_SA(1, 0), cA + kstep, voffA); PG8_STAGE(PG8_SB(1, 1), cB + hstepB + kstep, voffB);
        PG8_WAIT_V(6); PG8_BAR;
    } else {
        PG8_STAGE(PG8_SB(0, 0), cB, voffB); PG8_STAGE(PG8_SA(0, 0), cA, voffA); PG8_STAGE(PG8_SB(0, 1), cB + hstepB, voffB); PG8_STAGE(PG8_SA(0, 1), cA + hstepA, voffA);
        if (wr == 1) PG8_BAR;
        PG8_WAIT_V(4); PG8_BAR;
        PG8_STAGE(PG8_SB(1, 0), cB + kstep, voffB); PG8_STAGE(PG8_SA(1, 0), cA + kstep, voffA); PG8_STAGE(PG8_SB(1, 1), cB + hstepB + kstep, voffB);
        PG8_WAIT_V(6); PG8_BAR;
    }
    for (;;) {
        const bool has_next = S.next(ui + 1, nxt);
        const char* nA = has_next ? (const char*)g.A + (size_t)nxt.pm * tstepA : cA; const char* nB = has_next ? (const char*)g.Bt + (size_t)nxt.pn * tstepB : cB;
        for (int t = 0; t < nt; t += 2) {
            const bool last = (t == nt - 2);
            const char* a1 = cA + (size_t)(t + 1) * kstep;
            const char* a2 = last ? nA : cA + (size_t)(t + 2) * kstep; const char* b2 = last ? nB : cB + (size_t)(t + 2) * kstep;
            const char* a3 = a2 + kstep; const char* b3 = b2 + kstep;
            if (last && has_next) S.a_ready(nxt);
            if constexpr (SP2) {
            PG8_LDB(B0, 0, 0); PG8_LDB(B1, 0, 1); PG8_SCHED; PG8_LDA(At, 0, 0); PG8_STAGE(PG8_SA(1, 1), a1 + hstepA, voffA);
            PG8_WAIT_V(8); PG8_WAIT_L(0); PG8_BAR; PG8_MMA(0, 0, At, B0); PG8_MMA(0, 1, At, B1); PG8_BAR; PG8_SCHED;
            PG8_LDA(At, 0, 1); PG8_STAGE(PG8_SB(0, 0), b2, voffB); PG8_STAGE(PG8_SB(0, 1), b2 + hstepB, voffB); PG8_STAGE(PG8_SA(0, 0), a2, voffA);
            PG8_WAIT_V(8); PG8_WAIT_L(0); PG8_BAR; PG8_MMA(1, 0, At, B0); PG8_MMA(1, 1, At, B1); PG8_BAR; PG8_SCHED;
            PG8_LDB(B0, 1, 0); PG8_LDB(B1, 1, 1); PG8_SCHED; PG8_LDA(At, 1, 0); PG8_STAGE(PG8_SA(0, 1), a2 + hstepA, voffA);
            PG8_WAIT_V(8); PG8_WAIT_L(0); PG8_BAR; PG8_MMA(0, 0, At, B0); PG8_MMA(0, 1, At, B1); PG8_BAR; PG8_SCHED;
            PG8_LDA(At, 1, 1); PG8_STAGE(PG8_SB(1, 0), b3, voffB); PG8_STAGE(PG8_SB(1, 1), b3 + hstepB, voffB); PG8_STAGE(PG8_SA(1, 0), a3, voffA);
            PG8_WAIT_V(8); PG8_WAIT_L(0); PG8_BAR; PG8_MMA(1, 0, At, B0); PG8_MMA(1, 1, At, B1); PG8_BAR; PG8_SCHED;
            } else {
            PG8_LDB(B0, 0, 0); PG8_SCHED; PG8_LDA(At, 0, 0); PG8_STAGE(PG8_SA(1, 1), a1 + hstepA, voffA);
            PG8_WAIT_L(8); PG8_BAR; PG8_WAIT_L(0); PG8_MMA(0, 0, At, B0); PG8_BAR; PG8_SCHED;
            PG8_LDB(B1, 0, 1); PG8_STAGE(PG8_SB(0, 0), b2, voffB);
            PG8_BAR; PG8_WAIT_L(0); PG8_MMA(0, 1, At, B1); PG8_BAR;
            PG8_LDA(At, 0, 1); PG8_STAGE(PG8_SA(0, 0), a2, voffA);
            PG8_BAR; PG8_WAIT_L(0); PG8_MMA(1, 0, At, B0); PG8_BAR; PG8_SCHED;
            PG8_STAGE(PG8_SB(0, 1), b2 + hstepB, voffB);
            PG8_WAIT_V(6); PG8_BAR; PG8_MMA(1, 1, At, B1); PG8_BAR;
            PG8_LDB(B0, 1, 0); PG8_SCHED; PG8_LDA(At, 1, 0); PG8_STAGE(PG8_SA(0, 1), a2 + hstepA, voffA);
            PG8_WAIT_L(8); PG8_BAR; PG8_WAIT_L(0); PG8_MMA(0, 0, At, B0); PG8_BAR; PG8_SCHED;
            PG8_LDB(B1, 1, 1); PG8_STAGE(PG8_SB(1, 0), b3, voffB);
            PG8_BAR; PG8_WAIT_L(0); PG8_MMA(0, 1, At, B1); PG8_BAR;
            PG8_LDA(At, 1, 1); PG8_STAGE(PG8_SA(1, 0), a3, voffA);
            PG8_BAR; PG8_WAIT_L(0); PG8_MMA(1, 0, At, B0); PG8_BAR; PG8_SCHED;
            PG8_STAGE(PG8_SB(1, 1), b3 + hstepB, voffB);
            PG8_WAIT_V(6); PG8_BAR; PG8_MMA(1, 1, At, B1); PG8_BAR;
            }
        }
        if constexpr (ALIGN_EPI) { if (wr == 0) PG8_BAR; }
        E(acc, cur, wr, wc, fr, fq); S.done(cur);
        if (!has_next) break;
#pragma unroll
        for (int a = 0; a < 2; ++a)
#pragma unroll
            for (int b = 0; b < 2; ++b)
#pragma unroll
                for (int m = 0; m < 4; ++m)
#pragma unroll
                    for (int n = 0; n < 2; ++n) acc[a][b][m][n] = (f32x4){0.f, 0.f, 0.f, 0.f};
        cur = nxt; cA = nA; cB = nB; ++ui;
        if constexpr (ALIGN_EPI) { if (wr == 1) PG8_BAR; }
    }
    PG8_WAIT_V(0);
    if constexpr (!ALIGN_EPI) { if (wr == 0) PG8_BAR; }
    PG8_BAR;
#undef PG8_SA
#undef PG8_SB
#undef PG8_STAGE
#undef PG8_LDA
#undef PG8_LDB
#undef PG8_MMA
#undef PG8_WAIT_V
#undef PG8_WAIT_L
#undef PG8_BAR
#undef PG8_SCHED
}
}
namespace pg8 {
struct EpiInProj {
    static constexpr bool PERM = true;
    bf16_t* Y; float* GLR;
    __device__ __forceinline__ void operator()(const f32x4 (&acc)[2][2][4][2], const Unit& u, int wr, int wc, int fr, int fq) const {
        const int colt = u.pn * BM, row0 = u.pm * BM + wr * 64 + fr;
        if (colt >= YW) {
            if (wc == 0 && fq < 2) {
#pragma unroll
                for (int ai = 0; ai < 2; ++ai)
#pragma unroll
                    for (int m = 0; m < 4; ++m) { float* p = GLR + (size_t)(row0 + ai * HALF + m * 16) * 16 + 8 * fq;
                        *(f32x4*)p = acc[ai][0][m][0]; *(f32x4*)(p + 4) = acc[ai][0][m][1]; }
            }
            return;
        }
        const int mode = (colt < Y_GK) ? 1 : ((colt >= Y_GR && colt < Y_SU) ? 2 : (colt >= Y_BG ? 3 : 0));
        const int col0 = colt + wc * 32 + 8 * fq;
#pragma unroll
        for (int ai = 0; ai < 2; ++ai)
#pragma unroll
            for (int m = 0; m < 4; ++m) { bf16_t* rowp = Y + (size_t)(row0 + ai * HALF + m * 16) * YW + col0;
#pragma unroll
                for (int bj = 0; bj < 2; ++bj) { f32x4 v0 = acc[ai][bj][m][0], v1 = acc[ai][bj][m][1];
                    if (mode == 1) { v0 *= 0.08838834764831845f; v1 *= 0.08838834764831845f; }
                    else if (mode == 2) {
#pragma unroll
                        for (int j = 0; j < 4; ++j) { v0[j] = fsilu(v0[j]); v1[j] = fsilu(v1[j]); } }
                    else if (mode == 3) {
#pragma unroll
                        for (int j = 0; j < 4; ++j) { v0[j] = fsigmoid(v0[j]); v1[j] = fsigmoid(v1[j]); } }
                    u32x4 w; w.x = cvt_pk_bf16(v0[0], v0[1]); w.y = cvt_pk_bf16(v0[2], v0[3]); w.z = cvt_pk_bf16(v1[0], v1[1]); w.w = cvt_pk_bf16(v1[2], v1[3]);
                    *(u32x4*)(rowp + bj * HALF) = w; } }
    }
};
struct EpiGlu {
    static constexpr bool PERM = true;
    const bf16_t* YG; bf16_t* OC;
    __device__ __forceinline__ void operator()(const f32x4 (&acc)[2][2][4][2], const Unit& u, int wr, int wc, int fr, int fq) const {
        const int row0 = u.pm * BM + wr * 64 + fr, col0 = u.pn * BM + wc * 32 + 8 * fq;
#pragma unroll
        for (int ai = 0; ai < 2; ++ai)
#pragma unroll
            for (int m = 0; m < 4; ++m) { const size_t row = (size_t)(row0 + ai * HALF + m * 16);
#pragma unroll
                for (int bj = 0; bj < 2; ++bj) { const f32x4 v0 = acc[ai][bj][m][0], v1 = acc[ai][bj][m][1];
                    const u32x4 y = *(const u32x4*)(YG + row * 768 + col0 + bj * HALF);
                    u32x4 w;
                    w.x = cvt_pk_bf16(lo_bf(y.x) * fsigmoid(v0[0]), hi_bf(y.x) * fsigmoid(v0[1])); w.y = cvt_pk_bf16(lo_bf(y.y) * fsigmoid(v0[2]), hi_bf(y.y) * fsigmoid(v0[3]));
                    w.z = cvt_pk_bf16(lo_bf(y.z) * fsigmoid(v1[0]), hi_bf(y.z) * fsigmoid(v1[1])); w.w = cvt_pk_bf16(lo_bf(y.w) * fsigmoid(v1[2]), hi_bf(y.w) * fsigmoid(v1[3]));
                    *(u32x4*)(OC + row * OCW + 1024 + col0 + bj * HALF) = w; } }
    }
};
template <int STAGE> struct EpiMerge {
    static constexpr bool PERM = true;
    const bf16_t* Y; float* T; bf16_t* O;
    __device__ __forceinline__ void operator()(const f32x4 (&acc)[2][2][4][2], const Unit& u, int wr, int wc, int fr, int fq) const {
        const int row0 = u.pm * BM + wr * 64 + fr, col0 = u.pn * BM + wc * 32 + 8 * fq;
#pragma unroll
        for (int ai = 0; ai < 2; ++ai)
#pragma unroll
            for (int m = 0; m < 4; ++m) { const size_t row = (size_t)(row0 + ai * HALF + m * 16);
#pragma unroll
                for (int bj = 0; bj < 2; ++bj) { const int c = col0 + bj * HALF;
                    const u32x4 gt = *(const u32x4*)(Y + row * YW + Y_BG + STAGE * 2048 + c);
                    f32x4 v0 = acc[ai][bj][m][0], v1 = acc[ai][bj][m][1];
                    v0[0] *= lo_bf(gt.x); v0[1] *= hi_bf(gt.x); v0[2] *= lo_bf(gt.y); v0[3] *= hi_bf(gt.y);
                    v1[0] *= lo_bf(gt.z); v1[1] *= hi_bf(gt.z); v1[2] *= lo_bf(gt.w); v1[3] *= hi_bf(gt.w);
                    float* tp = T + row * DM + c;
                    if (STAGE > 0) { v0 += *(const f32x4*)tp; v1 += *(const f32x4*)(tp + 4); }
                    if (STAGE < 2) { *(f32x4*)tp = v0; *(f32x4*)(tp + 4) = v1; }
                    else { u32x4 w; w.x = cvt_pk_bf16(v0[0], v0[1]); w.y = cvt_pk_bf16(v0[2], v0[3]); w.z = cvt_pk_bf16(v1[0], v1[1]); w.w = cvt_pk_bf16(v1[2], v1[3]);
                        *(u32x4*)(O + row * DM + c) = w; } } }
    }
};
struct EpiResid {
    static constexpr bool PERM = true;
    const float* X; float* Z; const float* gate;
    __device__ __forceinline__ void operator()(const f32x4 (&acc)[2][2][4][2], const Unit& u, int wr, int wc, int fr, int fq) const {
        const int row0 = u.pm * BM + wr * 64 + fr, col0 = u.pn * BM + wc * 32 + 8 * fq;
        const int cond = (u.pm % 9 == 0) ? 4 : (u.pm / 9);
        const float* gp = gate + (size_t)cond * NMOD + col0;
        f32x4 g[2][2];
#pragma unroll
        for (int bj = 0; bj < 2; ++bj) { g[bj][0] = *(const f32x4*)(gp + bj * HALF); g[bj][1] = *(const f32x4*)(gp + bj * HALF + 4); }
#pragma unroll
        for (int ai = 0; ai < 2; ++ai)
#pragma unroll
            for (int m = 0; m < 4; ++m) { const size_t off = (size_t)(row0 + ai * HALF + m * 16) * DM + col0;
#pragma unroll
                for (int bj = 0; bj < 2; ++bj) {
                    const f32x4 x0 = *(const f32x4*)(X + off + bj * HALF), x1 = *(const f32x4*)(X + off + bj * HALF + 4);
                    *(f32x4*)(Z + off + bj * HALF) = x0 * DN_ALPHA + g[bj][0] * acc[ai][bj][m][0];
                    *(f32x4*)(Z + off + bj * HALF + 4) = x1 * DN_ALPHA + g[bj][1] * acc[ai][bj][m][1]; } }
    }
};
struct EpiSwiglu {
    static constexpr bool PERM = true;
    bf16_t* ACT;
    __device__ __forceinline__ void operator()(const f32x4 (&acc)[2][2][4][2], const Unit& u, int wr, int wc, int fr, int fq) const {
        const int row0 = u.pm * BM + wr * 64 + fr, col0 = u.pn * HALF + wc * 32 + 8 * fq;
#pragma unroll
        for (int ai = 0; ai < 2; ++ai)
#pragma unroll
            for (int m = 0; m < 4; ++m) { const f32x4 a0 = acc[ai][0][m][0], a1 = acc[ai][0][m][1], b0 = acc[ai][1][m][0], b1 = acc[ai][1][m][1];
                u32x4 w; w.x = cvt_pk_bf16(fsilu(a0[0]) * b0[0], fsilu(a0[1]) * b0[1]); w.y = cvt_pk_bf16(fsilu(a0[2]) * b0[2], fsilu(a0[3]) * b0[3]);
                w.z = cvt_pk_bf16(fsilu(a1[0]) * b1[0], fsilu(a1[1]) * b1[1]); w.w = cvt_pk_bf16(fsilu(a1[2]) * b1[2], fsilu(a1[3]) * b1[3]);
                *(u32x4*)(ACT + (size_t)(row0 + ai * HALF + m * 16) * DFF + col0) = w; }
    }
};
}
namespace att {
constexpr int D = 128, NW = 8, QBLK = 32, KVBLK = 64;
constexpr float SCALE = 0.088388347648318440f;
constexpr float THR = 8.f;
#ifndef ATT_SDEPTH
#define ATT_SDEPTH 1
#endif
constexpr int SDEPTH = ATT_SDEPTH;
constexpr int LDQ = 1024, LDK = 256, LDV = YW, LDO = OCW;
constexpr size_t SHM_V = KVBLK * D * 2, SHM_K = KVBLK * D * 2, SHM_ATTN = 2 * SHM_V + 2 * SHM_K + NW * 64 * 4;
#define KSWZ(row, colB) ((row) * 256 + ((colB) ^ (((row) & 7) << 4)))
#define SBAR() __builtin_amdgcn_sched_barrier(0)
__device__ __forceinline__ int crow(int r, int hi) { return (r & 3) + 8 * (r >> 2) + 4 * hi; }
__device__ __forceinline__ bf16x8 ld8(const bf16_t* p) { return *reinterpret_cast<const bf16x8*>(p); }

__device__ __forceinline__ void partialSM(f32x16& p0, f32x16& p1, float& m_reg, float& mn, float& alpha) {
  constexpr float C = SCALE * 1.4426950408889634f;
  float pmax = p0[0]; for (int r = 1; r < 16; ++r) pmax = fmaxf(pmax, p0[r]); for (int r = 0; r < 16; ++r) pmax = fmaxf(pmax, p1[r]);
  { auto rr = __builtin_amdgcn_permlane32_swap(__float_as_uint(pmax), __float_as_uint(pmax), false, false);
    pmax = fmaxf(__uint_as_float(rr[0]), __uint_as_float(rr[1])); }
  if (__builtin_expect(__all(pmax - m_reg <= THR / SCALE), 1)) { mn = m_reg; alpha = 1.f; }
  else { mn = fmaxf(m_reg, pmax); alpha = __builtin_amdgcn_exp2f((m_reg - mn) * C); m_reg = mn; }
  float mnC = -mn * C;
  for (int r = 0; r < 16; ++r) p0[r] = fmaf(p0[r], C, mnC); for (int r = 0; r < 16; ++r) p1[r] = fmaf(p1[r], C, mnC);
  for (int r = 0; r < 16; ++r) p0[r] = __builtin_amdgcn_exp2f(p0[r]);
}
__device__ __forceinline__ void finishSM(f32x16& p0, f32x16& p1, float alpha, float& l_reg, bf16x8& pa0, bf16x8& pa1, bf16x8& pa2, bf16x8& pa3) {
  for (int r = 0; r < 16; ++r) p1[r] = __builtin_amdgcn_exp2f(p1[r]);
  float ps = 0; for (int r = 0; r < 16; ++r) ps += p0[r]; for (int r = 0; r < 16; ++r) ps += p1[r];
  { auto rr = __builtin_amdgcn_permlane32_swap(__float_as_uint(ps), __float_as_uint(ps), false, false);
    ps = __uint_as_float(rr[0]) + __uint_as_float(rr[1]); }
  l_reg = l_reg * alpha + ps;
#define PK4(P, BASE, OUT) do { unsigned a0 = cvt_pk_bf16(P[BASE + 0], P[BASE + 1]), a1 = cvt_pk_bf16(P[BASE + 2], P[BASE + 3]);   \
    unsigned b0 = cvt_pk_bf16(P[BASE + 4], P[BASE + 5]), b1 = cvt_pk_bf16(P[BASE + 6], P[BASE + 7]);                              \
    auto r0 = __builtin_amdgcn_permlane32_swap(a0, b0, false, false); auto r1 = __builtin_amdgcn_permlane32_swap(a1, b1, false, false); \
    u32x4 w = {r0[0], r1[0], r0[1], r1[1]}; OUT = *reinterpret_cast<bf16x8*>(&w); } while (0)
  PK4(p0, 0, pa0); PK4(p0, 8, pa1); PK4(p1, 0, pa2); PK4(p1, 8, pa3);
#undef PK4
}
__device__ __forceinline__ void qkt(f32x16& p0, f32x16& p1, const bf16_t* Ks, const bf16x8* qr, int r32, int hi) {
  p0 = f32x16{}; p1 = f32x16{};
  for (int d0 = 0; d0 < 8; ++d0) { int cb = (d0 * 16 + hi * 8) * 2;
    bf16x8 b0 = *reinterpret_cast<const bf16x8*>((const char*)Ks + KSWZ(r32, cb));
    bf16x8 b1 = *reinterpret_cast<const bf16x8*>((const char*)Ks + KSWZ(32 + r32, cb));
    p0 = __builtin_amdgcn_mfma_f32_32x32x16_bf16(b0, qr[d0], p0, 0, 0, 0);
    p1 = __builtin_amdgcn_mfma_f32_32x32x16_bf16(b1, qr[d0], p1, 0, 0, 0); }
}
__device__ __forceinline__ int v_st(int k, int c) { const int kk = (k & ~0xC) | ((k & 4) << 1) | ((k & 8) >> 1); return ((kk >> 3) * 4 + (c >> 5)) * 512 + ((kk & 7) * 32 + (c & 31)) * 2; }
__device__ __forceinline__ int v_rd_base(int lane) { return ((lane & 3) << 3) | (((lane >> 2) & 3) << 6) | (((lane >> 4) & 1) << 5) | (((lane >> 5) & 1) << 8); }
constexpr int v_rd_off(int d0, int ks, int half) { return d0 * 512 + ks * 4096 + half * 2048; }
template <int OFF> __device__ __forceinline__ s16x4 tr_read(int vb) {
  s16x4 r; asm volatile("ds_read_b64_tr_b16 %0, %1 offset:%2" : "=&v"(r) : "v"(vb), "i"(OFF) : "memory"); return r;
}
template <int D0> __device__ __forceinline__ void pv_one(f32x16& od, int vb, bf16x8 pa0, bf16x8 pa1, bf16x8 pa2, bf16x8 pa3) {
  const s16x4 l0 = tr_read<v_rd_off(D0, 0, 0)>(vb), h0 = tr_read<v_rd_off(D0, 0, 1)>(vb), l1 = tr_read<v_rd_off(D0, 1, 0)>(vb), h1 = tr_read<v_rd_off(D0, 1, 1)>(vb);
  const s16x4 l2 = tr_read<v_rd_off(D0, 2, 0)>(vb), h2 = tr_read<v_rd_off(D0, 2, 1)>(vb), l3 = tr_read<v_rd_off(D0, 3, 0)>(vb), h3 = tr_read<v_rd_off(D0, 3, 1)>(vb);
  asm volatile("s_waitcnt lgkmcnt(0)" ::: "memory"); SBAR();
#define PK(L, H) (bf16x8){L[0], L[1], L[2], L[3], H[0], H[1], H[2], H[3]}
  od = __builtin_amdgcn_mfma_f32_32x32x16_bf16(pa0, PK(l0, h0), od, 0, 0, 0);
  od = __builtin_amdgcn_mfma_f32_32x32x16_bf16(pa1, PK(l1, h1), od, 0, 0, 0);
  od = __builtin_amdgcn_mfma_f32_32x32x16_bf16(pa2, PK(l2, h2), od, 0, 0, 0);
  od = __builtin_amdgcn_mfma_f32_32x32x16_bf16(pa3, PK(l3, h3), od, 0, 0, 0);
#undef PK
}
__device__ __forceinline__ void pv_d0(f32x16* o, int vb, bf16x8 pa0, bf16x8 pa1, bf16x8 pa2, bf16x8 pa3) {
  pv_one<0>(o[0], vb, pa0, pa1, pa2, pa3); pv_one<1>(o[1], vb, pa0, pa1, pa2, pa3); pv_one<2>(o[2], vb, pa0, pa1, pa2, pa3); pv_one<3>(o[3], vb, pa0, pa1, pa2, pa3);
}
__device__ __forceinline__ void attn_dense_body(const bf16_t* __restrict__ Qb, const bf16_t* __restrict__ Kh, const bf16_t* __restrict__ Vh,
                                                bf16_t* __restrict__ Ob, int seq, char* lds) {
  const int tid = opaque(threadIdx.x), wid = tid >> 6, lane = tid & 63, r32 = lane & 31, hi = lane >> 5;
  bf16_t* V_lds = (bf16_t*)lds; bf16_t* K_lds = (bf16_t*)(lds + 2 * SHM_V);
  float* ws = (float*)(lds + 2 * SHM_V + 2 * SHM_K) + wid * 64; float* li_l = ws; float* al_l = ws + 32;
  float m_reg = -1e30f, l_reg = 0; f32x16 o[4] = {}; bf16x8 qr[8];
  const bf16_t* Qw = Qb + (unsigned)((wid * QBLK + r32) * LDQ + hi * 8);
#pragma unroll
  for (int d0 = 0; d0 < 8; ++d0) qr[d0] = ld8(Qw + d0 * 16);
  const int sr = tid >> 4, sc = (tid & 15) * 8, vst0 = v_st(sr, sc), vst1 = v_st(32 + sr, sc);
  const int vb0 = (int)(uintptr_t)V_lds + v_rd_base(lane);
  struct { bf16x8 vs0, vs1, ks0, ks1; } sr_[SDEPTH];
  const unsigned voff0 = (unsigned)(sr * LDV + sc), voff1 = (unsigned)((32 + sr) * LDV + sc), koff0 = (unsigned)(sr * LDK + sc), koff1 = (unsigned)((32 + sr) * LDK + sc);
#define SLOAD(i, k0) do { const bf16_t* vb_ = Vh + (size_t)(k0) * LDV; const bf16_t* kb_ = Kh + (size_t)(k0) * LDK; \
    sr_[i].vs0 = ld8(vb_ + voff0); sr_[i].vs1 = ld8(vb_ + voff1); sr_[i].ks0 = ld8(kb_ + koff0); sr_[i].ks1 = ld8(kb_ + koff1); } while (0)
#define SWRITE(b, i) do { *(bf16x8*)((char*)V_lds + (b) * SHM_V + vst0) = sr_[i].vs0;          \
    *(bf16x8*)((char*)V_lds + (b) * SHM_V + vst1) = sr_[i].vs1; int kc = sc * 2;               \
    *(bf16x8*)((char*)K_lds + (b) * SHM_K + KSWZ(sr, kc)) = sr_[i].ks0;                       \
    *(bf16x8*)((char*)K_lds + (b) * SHM_K + KSWZ(32 + sr, kc)) = sr_[i].ks1; } while (0)
#define SWAIT() do { if constexpr (SDEPTH == 2) asm volatile("s_waitcnt vmcnt(4)" ::: "memory"); else asm volatile("s_waitcnt vmcnt(0)" ::: "memory"); } while (0)
#define RESC(a) do { if (__any((a) < 1.f)) { if (hi == 0) al_l[r32] = (a); asm volatile("s_waitcnt lgkmcnt(0)" ::: "memory"); \
    for (int d = 0; d < 4; ++d) for (int r = 0; r < 16; ++r) o[d][r] *= al_l[crow(r, hi)]; } } while (0)
  f32x16 pA0, pA1, pB0, pB1; float mnA, mnB, alA, alB; bf16x8 pa0, pa1, pa2, pa3; const int NT = seq / KVBLK;
  constexpr int SE = 0, SO = SDEPTH - 1;
  SLOAD(SE, 0); asm volatile("s_waitcnt vmcnt(0)" ::: "memory"); SWRITE(0, SE); __syncthreads();
  qkt(pA0, pA1, K_lds, qr, r32, hi); partialSM(pA0, pA1, m_reg, mnA, alA);
  SLOAD(SO, KVBLK); if constexpr (SDEPTH == 2) { if (2 < NT) SLOAD(SE, 2 * KVBLK); }
  SWAIT(); SWRITE(1, SO); __syncthreads();
  for (int j = 1; j + 1 < NT; j += 2) {
    SBAR(); qkt(pB0, pB1, (bf16_t*)((char*)K_lds + SHM_K), qr, r32, hi);
    finishSM(pA0, pA1, alA, l_reg, pa0, pa1, pa2, pa3); SBAR();
    SLOAD(SO, (j + SDEPTH) * KVBLK); SBAR();
    pv_d0(o, vb0, pa0, pa1, pa2, pa3); partialSM(pB0, pB1, m_reg, mnB, alB);
    __syncthreads(); SWAIT(); SWRITE(0, SE);
    RESC(alB); __syncthreads();
    SBAR(); qkt(pA0, pA1, K_lds, qr, r32, hi);
    finishSM(pB0, pB1, alB, l_reg, pa0, pa1, pa2, pa3); SBAR();
    if (SDEPTH == 1 || j + 3 < NT) SLOAD(SE, (j + 1 + SDEPTH) * KVBLK); SBAR();
    pv_d0(o, vb0 + (int)SHM_V, pa0, pa1, pa2, pa3); partialSM(pA0, pA1, m_reg, mnA, alA);
    __syncthreads(); SWAIT(); SWRITE(1, SO);
    RESC(alA); __syncthreads();
  }
  SBAR(); qkt(pB0, pB1, (bf16_t*)((char*)K_lds + SHM_K), qr, r32, hi);
  finishSM(pA0, pA1, alA, l_reg, pa0, pa1, pa2, pa3); SBAR();
  pv_d0(o, vb0, pa0, pa1, pa2, pa3); partialSM(pB0, pB1, m_reg, mnB, alB);
  __syncthreads(); RESC(alB);
  finishSM(pB0, pB1, alB, l_reg, pa0, pa1, pa2, pa3); SBAR();
  pv_d0(o, vb0 + (int)SHM_V, pa0, pa1, pa2, pa3);
  if (hi == 0) li_l[r32] = l_reg; asm volatile("s_waitcnt lgkmcnt(0)" ::: "memory");
  float rli[16];
#pragma unroll
  for (int r = 0; r < 16; ++r) rli[r] = __builtin_amdgcn_rcpf(li_l[crow(r, hi)]);
  const unsigned ooff = (unsigned)((wid * QBLK + 4 * hi) * LDO + r32);
#pragma unroll
  for (int r = 0; r < 16; ++r) { const int orow = (r & 3) + 8 * (r >> 2);
#pragma unroll
    for (int d0 = 0; d0 < 4; ++d0) Ob[ooff + (unsigned)(orow * LDO + d0 * 32)] = f2bf(o[d0][r] * rli[r]); }
#undef SLOAD
#undef SWRITE
#undef SWAIT
#undef RESC
}
#undef KSWZ
}
#define XB_TMO      128
#define XB_XCNT(j)  (256  + 64 * (j))
#define XB_XSUB(j)  (1280 + 64 * (j))
#define XB_XGEN(j)  (2304 + 64 * (j))
#define XB_TOP      3328
#define XB_TOPGEN   3392
#define XCD_BAR_WORDS 3456
#define XB_SPIN_CAP (1u << 18)

__device__ __forceinline__ unsigned xb_ld(unsigned* p)              { return __hip_atomic_load(p, __ATOMIC_RELAXED, __HIP_MEMORY_SCOPE_AGENT); }
__device__ __forceinline__ unsigned xb_add(unsigned* p, unsigned v) { return __hip_atomic_fetch_add(p, v, __ATOMIC_RELAXED, __HIP_MEMORY_SCOPE_AGENT); }
__device__ __forceinline__ unsigned xb_xcc_id() { return (unsigned)__builtin_amdgcn_s_getreg((3 << 11) | 20) & 0xFu; }
#define XB_SPIN(cond, bar) do { unsigned _sp = 0; while (cond) { __builtin_amdgcn_s_sleep(1); \
    if ((++_sp & 255u) == 0u) { if (xb_ld(&(bar)[XB_TMO])) break; if (_sp > XB_SPIN_CAP) { atomicAdd(&(bar)[XB_TMO], 1u); break; } } } } while (0)

struct XcdBarrier {
    unsigned* bar; unsigned x;
    volatile LAS unsigned* st;
};
__device__ __forceinline__ XcdBarrier xcd_barrier_post(unsigned* bar, volatile LAS unsigned* st) {
    XcdBarrier b; b.bar = bar; b.x = xb_xcc_id(); b.st = st;
    if (threadIdx.x == 0) (void)xb_add(&bar[XB_XCNT(b.x)], 1u);
    return b;
}
__device__ __forceinline__ void xcd_barrier_complete(unsigned* bar, unsigned x, unsigned& nloc, unsigned& nx) {
    const unsigned G = gridDim.x * gridDim.y * gridDim.z;
    unsigned sum, cnt, mine, sp = 0u;
    for (;;) {
        sum = 0u; cnt = 0u; mine = 0u;
#pragma unroll
        for (unsigned j = 0; j < 16; ++j) { const unsigned c = xb_ld(&bar[XB_XCNT(j)]); sum += c; cnt += (c > 0u) ? 1u : 0u; mine = (j == x) ? c : mine; }
        if (sum == G) break;
        __builtin_amdgcn_s_sleep(1);
        if ((++sp & 255u) == 0u) { if (xb_ld(&bar[XB_TMO])) break; if (sp > XB_SPIN_CAP) { atomicAdd(&bar[XB_TMO], 1u); break; } }
    }
    nloc = mine > 0u ? mine : 1u; nx = cnt > 0u ? cnt : 1u;
}
__device__ __forceinline__ void xcd_barrier(const XcdBarrier& b) {
    asm volatile("s_waitcnt vmcnt(0)" ::: "memory");
    __syncthreads();
    if (threadIdx.x == 0) {
        unsigned* bar = b.bar;
        __builtin_amdgcn_s_waitcnt(0);
        unsigned nloc = b.st[0], nx = b.st[1];
        if (nloc == 0u) { xcd_barrier_complete(bar, b.x, nloc, nx); b.st[0] = nloc; b.st[1] = nx; }
        const unsigned old = xb_add(&bar[XB_XSUB(b.x)], 1u);
        const unsigned gen = old / nloc;
        if (old + 1u == (gen + 1u) * nloc) {
            __builtin_amdgcn_fence(__ATOMIC_RELEASE, "agent");
            asm volatile("s_waitcnt vmcnt(0)" ::: "memory");
            const unsigned og = xb_add(&bar[XB_TOP], 1u);
            const unsigned tg = og / nx;
            if (og + 1u == (tg + 1u) * nx) xb_add(&bar[XB_TOPGEN], 1u);
            else XB_SPIN(xb_ld(&bar[XB_TOPGEN]) == tg, bar);
            __builtin_amdgcn_fence(__ATOMIC_ACQUIRE, "agent");
            xb_add(&bar[XB_XGEN(b.x)], 1u);
            asm volatile("s_waitcnt vmcnt(0)" ::: "memory");
        } else {
            XB_SPIN(xb_ld(&bar[XB_XGEN(b.x)]) == gen, bar);
            __builtin_amdgcn_fence(__ATOMIC_ACQUIRE, "agent");
            asm volatile("s_waitcnt vmcnt(0)" ::: "memory");
        }
    }
    __syncthreads();
}
constexpr int NWAVES = 8;
constexpr int RING_BYTES = 131072, LDSCTL_OFF = 135168, MISC_OFF = LDSCTL_OFF + 320, LDS_BYTES = 147456;
constexpr int CW_BAR = 4096, CW_QUEUE = 8192;
constexpr int NPH_PRO = 3, NPH_LAYER = 11, NPH_TOTAL = NPH_PRO + DEPTH * NPH_LAYER;
struct Args { const float* in[31]; float* out; unsigned char* ws; int ph_lo, ph_hi; };
enum { I_X = 0, I_C, I_CTX, I_CCTX, I_WADA, I_BADA, I_WIN, I_WGATE, I_BGATE, I_GLANW, I_LAMRE, I_LAMIM, I_LOGDT, I_BRE, I_BIM, I_CRE, I_CIM, I_S5D, I_WGLU, I_QNW, I_KNW,
       I_WPG, I_WPS, I_WPA, I_WOUT, I_LN1W, I_LN1B, I_LN2W, I_LN2B, I_WFFI, I_WFFO };

template <int MAP> __device__ __forceinline__ int map_col(int n) {
    if (MAP == 1) return n < 3072 ? n : (n < 11520 ? n + 16 : (n < 11536 ? n - 8448 : -1));
    if (MAP == 2) { const int j = n >> 8, r = n & 255; return r < 128 ? 128 * j + r : DFF + 128 * j + (r - 128); }
    return n;
}
template <int MAP> __device__ __forceinline__ void transpose_item(const float* src, int sld, bf16_t* dst, int dld, int kb, int nb, LAS float* scr, int lane) {
    const int k0 = 64 * kb, n0 = 64 * nb, sc = map_col<MAP>(n0 + lane);
    const float* sp = src + (size_t)k0 * sld + (sc >= 0 ? sc : 0);
#pragma unroll 8
    for (int i = 0; i < 64; ++i) { const float v = sp[(size_t)i * sld]; scr[i * 65 + lane] = (sc >= 0) ? v : 0.f; }
    LDS_WAIT();
    const int c = lane & 7, ns = lane >> 3;
#pragma unroll
    for (int jn = 0; jn < 8; ++jn) { const int nn = jn * 8 + ns; const LAS float* s = scr + (8 * c) * 65 + nn;
        u32x4 o; o.x = cvt_pk_bf16(s[0 * 65], s[1 * 65]); o.y = cvt_pk_bf16(s[2 * 65], s[3 * 65]); o.z = cvt_pk_bf16(s[4 * 65], s[5 * 65]); o.w = cvt_pk_bf16(s[6 * 65], s[7 * 65]);
        *(u32x4*)(dst + (size_t)(n0 + nn) * dld + k0 + 8 * c) = o; }
    LDS_WAIT();
}
__device__ __forceinline__ void p0_prologue(const Args& a, LAS unsigned char* lds) {
    const int tid = threadIdx.x, lane = tid & 63, wave = __builtin_amdgcn_readfirstlane(tid >> 6);
    const int gw = blockIdx.x * NWAVES + wave, NGW = gridDim.x * NWAVES;
    LAS float* scr = (LAS float*)(lds + wave * 16640);
    constexpr int I_IN = 32 * 184, I_GLU = 12 * 12, I_CG = 16 * 32, I_CS = 12 * 32, I_CA = 16 * 32, I_OUT = 32 * 32, I_FFI = 32 * 176, I_FFO = 88 * 32;
    constexpr int PER_L = I_IN + I_GLU + I_CG + I_CS + I_CA + I_OUT + I_FFI + I_FFO;
    for (int it = gw; it < DEPTH * PER_L; it += NGW) {
        const int l = it / PER_L; int r = it % PER_L;
        unsigned char* wl = a.ws + WS_W + (size_t)l * WL_STRIDE;
        if (r < I_IN) { transpose_item<1>(a.in[I_WIN] + (size_t)l * DM * 11536, 11536, (bf16_t*)(wl + WL_IN), DM, r / 184, r % 184, scr, lane); continue; } r -= I_IN;
        if (r < I_GLU) { transpose_item<0>(a.in[I_WGLU] + (size_t)l * 768 * 768, 768, (bf16_t*)(wl + WL_GLU), 768, r / 12, r % 12, scr, lane); continue; } r -= I_GLU;
        if (r < I_CG) { transpose_item<0>(a.in[I_WPG] + (size_t)l * 1024 * DM, DM, (bf16_t*)(wl + WL_CAT), OCW, r / 32, r % 32, scr, lane); continue; } r -= I_CG;
        if (r < I_CS) { transpose_item<0>(a.in[I_WPS] + (size_t)l * 768 * DM, DM, (bf16_t*)(wl + WL_CAT) + 1024, OCW, r / 32, r % 32, scr, lane); continue; } r -= I_CS;
        if (r < I_CA) { transpose_item<0>(a.in[I_WPA] + (size_t)l * 1024 * DM, DM, (bf16_t*)(wl + WL_CAT) + 1792, OCW, r / 32, r % 32, scr, lane); continue; } r -= I_CA;
        if (r < I_OUT) { transpose_item<0>(a.in[I_WOUT] + (size_t)l * DM * DM, DM, (bf16_t*)(wl + WL_OUT), DM, r / 32, r % 32, scr, lane); continue; } r -= I_OUT;
        if (r < I_FFI) { transpose_item<2>(a.in[I_WFFI] + (size_t)l * DM * 2 * DFF, 2 * DFF, (bf16_t*)(wl + WL_FFI), DM, r / 176, r % 176, scr, lane); continue; } r -= I_FFI;
        transpose_item<0>(a.in[I_WFFO] + (size_t)l * DFF * DM, DM, (bf16_t*)(wl + WL_FFO), DFF, r / 32, r % 32, scr, lane);
    }
    __syncthreads();
    LAS float* SL = (LAS float*)lds;
    for (int i = tid; i < 5 * DM; i += NWAVES * 64) { const int r = i / DM, k = i % DM; const float v = r < 4 ? a.in[I_C][r * DM + k] : a.in[I_CCTX][k]; SL[i] = v / (1.0f + expf(-v)); }
    __syncthreads();
    float* MODP = (float*)(a.ws + WS_MODP);
    for (int it = gw; it < DEPTH * ADA_KS * 48; it += NGW) {
        const int l = it / (ADA_KS * 48), rem = it % (ADA_KS * 48), ks = rem / 48, nb = rem % 48;
        const float* wp = a.in[I_WADA] + ((size_t)l * DM + ks * 64) * NMOD + nb * 256 + lane * 4;
        f32x4 acc[5];
#pragma unroll
        for (int r = 0; r < 5; ++r) acc[r] = (f32x4){0.f, 0.f, 0.f, 0.f};
#pragma unroll 8
        for (int kk = 0; kk < 64; ++kk) { const f32x4 w = *(const f32x4*)(wp + (size_t)kk * NMOD); const int k = ks * 64 + kk;
#pragma unroll
            for (int r = 0; r < 5; ++r) acc[r] += w * SL[r * DM + k]; }
#pragma unroll
        for (int r = 0; r < 5; ++r) *(f32x4*)(MODP + ((size_t)((l * ADA_KS + ks) * 5 + r)) * NMOD + nb * 256 + lane * 4) = acc[r];
    }
    float* SA = (float*)(a.ws + WS_S5A); bf16_t* KB = (bf16_t*)(a.ws + WS_S5KB); bf16_t* CT = (bf16_t*)(a.ws + WS_S5CT);
    for (int i = blockIdx.x * (NWAVES * 64) + tid; i < DEPTH * 2 * 48 * 64; i += gridDim.x * NWAVES * 64) {
        const int p = i & 63, base = i >> 6, g = base % 48, l = base / 96;
        const double lre = (double)a.in[I_LAMRE][i], lim = (double)a.in[I_LAMIM][i], dt = exp((double)a.in[I_LOGDT][base]);
        const double mag = exp(lre * dt), are = mag * cos(lim * dt), aim = mag * sin(lim * dt), den = lre * lre + lim * lim;
        const double nr = are - 1.0, ni = aim, kre = (nr * lre + ni * lim) / den, kim = (ni * lre - nr * lim) / den;
        SA[2 * i] = (float)are; SA[2 * i + 1] = (float)aim;
        const float* bre = a.in[I_BRE] + ((size_t)(l * 48 + g) * 64 + p) * 16; const float* bim = a.in[I_BIM] + ((size_t)(l * 48 + g) * 64 + p) * 16;
        for (int c = 0; c < 16; ++c) { const double br = bre[c], bi = bim[c];
            KB[((size_t)base * 128 + p) * 16 + c] = f2bf((float)(kre * br - kim * bi)); KB[((size_t)base * 128 + 64 + p) * 16 + c] = f2bf((float)(kre * bi + kim * br)); }
        for (int c = 0; c < 16; ++c) { const size_t ci = ((size_t)base * 16 + c) * 64 + p;
            CT[((size_t)base * 16 + c) * 128 + p] = f2bf(a.in[I_CRE][ci]); CT[((size_t)base * 16 + c) * 128 + 64 + p] = f2bf(-a.in[I_CIM][ci]); }
    }
}
__device__ __forceinline__ void p1_mod(const Args& a) {
    const float* MODP = (const float*)(a.ws + WS_MODP); float* MOD = (float*)(a.ws + WS_MOD);
    for (int i = blockIdx.x * (NWAVES * 64) + threadIdx.x; i < DEPTH * 5 * NMOD; i += gridDim.x * NWAVES * 64) {
        const int l = i / (5 * NMOD), rem = i % (5 * NMOD), r = rem / NMOD, n = rem % NMOD;
        float s = a.in[I_BADA][l * NMOD + n];
        for (int ks = 0; ks < ADA_KS; ++ks) s += MODP[((size_t)((l * ADA_KS + ks) * 5 + r)) * NMOD + n];
        MOD[i] = s;
    }
}
__device__ __forceinline__ void p2_input(const Args& a) {
    const int tid_ = opaque(threadIdx.x), lane = tid_ & 63, wave = tid_ >> 6, gw = blockIdx.x * NWAVES + wave, NGW = gridDim.x * NWAVES;
    const float* MOD = (const float*)(a.ws + WS_MOD); float* X = (float*)(a.ws + WS_X); bf16_t* H = (bf16_t*)(a.ws + WS_H);
    for (int m = gw; m < MROWS; m += NGW) {
        const int b = m / TOK, t = m % TOK, cond = t < NCTX ? 4 : b;
        const float* src = t < NCTX ? a.in[I_CTX] + ((size_t)b * NCTX + t) * DM : a.in[I_X] + ((size_t)b * SEQ + (t - NCTX)) * DM;
        const float* sh = MOD + (size_t)cond * NMOD; const float* sc = sh + DM;
#pragma unroll
        for (int j = 0; j < 8; ++j) { const int col = lane * 4 + 256 * j; const f32x4 v = *(const f32x4*)(src + col);
            *(f32x4*)(X + (size_t)m * DM + col) = v;
            const f32x4 s1 = *(const f32x4*)(sc + col), s0 = *(const f32x4*)(sh + col); const f32x4 h = v * (1.0f + s1) + s0;
            u32x2 w; w.x = cvt_pk_bf16(h[0], h[1]); w.y = cvt_pk_bf16(h[2], h[3]); *(u32x2*)(H + (size_t)m * DM + col) = w; }
    }
}
__device__ __forceinline__ void ln_phase(const Args& a, const float* lnw, const float* lnb, const float* modp, float* out) {
    const int tid_ = opaque(threadIdx.x), lane = tid_ & 63, wave = tid_ >> 6, gw = blockIdx.x * NWAVES + wave, NGW = gridDim.x * NWAVES;
    const float* Z = (const float*)(a.ws + WS_Z); float* X = (float*)(a.ws + WS_X); bf16_t* H = (bf16_t*)(a.ws + WS_H);
    for (int m = gw; m < MROWS; m += NGW) {
        const int b = m / TOK, t = m % TOK, cond = t < NCTX ? 4 : b;
        if (out && t < NCTX) continue;
        f32x4 v[8]; float s = 0.f;
#pragma unroll
        for (int j = 0; j < 8; ++j) { v[j] = *(const f32x4*)(Z + (size_t)m * DM + lane * 4 + 256 * j); s += (v[j][0] + v[j][1]) + (v[j][2] + v[j][3]); }
        const float mean = wave_sum(s) * (1.0f / DM); float q = 0.f;
#pragma unroll
        for (int j = 0; j < 8; ++j) { v[j] = v[j] - mean; q += (v[j][0] * v[j][0] + v[j][1] * v[j][1]) + (v[j][2] * v[j][2] + v[j][3] * v[j][3]); }
        const float rstd = 1.0f / sqrtf(wave_sum(q) * (1.0f / DM) + LN_EPS);
#pragma unroll
        for (int j = 0; j < 8; ++j) { const int col = lane * 4 + 256 * j;
            const f32x4 xn = v[j] * rstd * *(const f32x4*)(lnw + col) + *(const f32x4*)(lnb + col);
            if (out) { *(f32x4*)(out + ((size_t)b * SEQ + (t - NCTX)) * DM + col) = xn; }
            else { *(f32x4*)(X + (size_t)m * DM + col) = xn;
                const f32x4 s0 = *(const f32x4*)(modp + (size_t)cond * NMOD + col), s1 = *(const f32x4*)(modp + (size_t)cond * NMOD + DM + col);
                const f32x4 h = xn * (1.0f + s1) + s0; u32x2 w; w.x = cvt_pk_bf16(h[0], h[1]); w.y = cvt_pk_bf16(h[2], h[3]); *(u32x2*)(H + (size_t)m * DM + col) = w; }
        }
    }
}
__device__ __forceinline__ void qk_phase(const Args& a, int l) {
    const int tid_ = opaque(threadIdx.x), lane = tid_ & 63, wave = tid_ >> 6, gw = blockIdx.x * NWAVES + wave, NGW = gridDim.x * NWAVES;
    const bf16_t* Y = (const bf16_t*)(a.ws + WS_Y); bf16_t* QN = (bf16_t*)(a.ws + WS_QN); bf16_t* KN = (bf16_t*)(a.ws + WS_KN);
    const float qw0 = a.in[I_QNW][l * 128 + 2 * lane], qw1 = a.in[I_QNW][l * 128 + 2 * lane + 1], kw0 = a.in[I_KNW][l * 128 + 2 * lane], kw1 = a.in[I_KNW][l * 128 + 2 * lane + 1];
    const float inv = powf(10000.0f, -(float)(lane & 31) * (1.0f / 32.0f));
    for (int m = gw; m < MROWS; m += NGW) {
        const int t = m % TOK; const bool lat = t >= NCTX; const int s = t - NCTX;
        float cs = 1.f, sn = 0.f;
#if defined(ABL) && ABL == 2
        if (false) {
#else
        if (lat) {
#endif
            const float pos = (lane < 32) ? (float)(s >> 6) : (float)(s & 63); const float ang = pos * inv; cs = cosf(ang); sn = sinf(ang); }
#pragma unroll
        for (int hh = 0; hh < 10; ++hh) {
            const bool isq = hh < 8;
            const unsigned pr = *(const unsigned*)(Y + (size_t)m * YW + (isq ? Y_AQ + hh * 128 : Y_AK + (hh - 8) * 128) + 2 * lane);
            float x0 = lo_bf(pr), x1 = hi_bf(pr);
            const float rstd = 1.0f / sqrtf(wave_sum(x0 * x0 + x1 * x1) * (1.0f / 128.0f) + LN_EPS);
            x0 *= rstd * (isq ? qw0 : kw0); x1 *= rstd * (isq ? qw1 : kw1);
            const float y0 = x0 * cs - x1 * sn, y1 = x0 * sn + x1 * cs;
            bf16_t* dst = isq ? QN + (size_t)m * 1024 + hh * 128 + 2 * lane : KN + (size_t)m * 256 + (hh - 8) * 128 + 2 * lane;
            *(unsigned*)dst = cvt_pk_bf16(y0, y1);
        }
    }
}
__device__ __forceinline__ void attn_unit(const Args& a, int u, char* lds) {
    const bf16_t* Y = (const bf16_t*)(a.ws + WS_Y); const bf16_t* QN = (const bf16_t*)(a.ws + WS_QN); const bf16_t* KN = (const bf16_t*)(a.ws + WS_KN); bf16_t* OC = (bf16_t*)(a.ws + WS_OCAT);
    int b, h, qrow, seq;
    if (u < 256) { const int grp = u >> 5, idx = u & 31; b = grp >> 1; h = (grp & 1) * 4 + (idx >> 3); qrow = b * TOK + NCTX + 256 * (idx & 7); seq = TOK; }
    else { const int uc = u - 256; b = uc >> 3; h = uc & 7; qrow = b * TOK; seq = NCTX; }
    const int kvh = h >> 2; const size_t krow = (size_t)b * TOK;
    __syncthreads();
    att::attn_dense_body(QN + (size_t)qrow * 1024 + h * 128, KN + krow * 256 + kvh * 128, Y + krow * YW + Y_AV + kvh * 128, OC + (size_t)qrow * OCW + 1792 + h * 128, seq, lds);
    __syncthreads();
}
__device__ __forceinline__ void gla_prep_phase(const Args& a, int l) {
    const int tid_ = opaque(threadIdx.x), lane = tid_ & 63, wave = tid_ >> 6, gw = blockIdx.x * NWAVES + wave, NGW = gridDim.x * NWAVES;
    const bf16_t* Y = (const bf16_t*)(a.ws + WS_Y); const float* GLR = (const float*)(a.ws + WS_GLR);
    bf16_t* QEg = (bf16_t*)(a.ws + WS_QE); bf16_t* KEg = (bf16_t*)(a.ws + WS_KE); bf16_t* KDTg = (bf16_t*)(a.ws + WS_KDT); bf16_t* VTg = (bf16_t*)(a.ws + WS_VT); float* DECg = (float*)(a.ws + WS_DEC);
    for (int it = gw; it < 2 * 1152; it += NGW) {
        if (it < 1152) {
            const int dir = it / 576, rem = it % 576, gc = rem >> 2, col = (rem & 3) * 128 + 2 * lane;
            const size_t m0 = (size_t)gc * 64;
            float wg0[16], wg1[16];
#pragma unroll
            for (int r = 0; r < 16; ++r) { const f32x2 w2 = *(const f32x2*)(a.in[I_WGATE] + ((size_t)(l * 2 + dir) * 16 + r) * 512 + col); wg0[r] = w2[0]; wg1[r] = w2[1]; }
            const f32x2 bg2 = *(const f32x2*)(a.in[I_BGATE] + (l * 2 + dir) * 512 + col);
#define GLA_GATE(j_, o0_, o1_) do { const float* gl_ = GLR + (m0 + (j_)) * 16; float p0_ = bg2[0], p1_ = bg2[1]; \
                _Pragma("unroll") for (int r4 = 0; r4 < 4; ++r4) { const f32x4 g4 = *(const f32x4*)(gl_ + 4 * r4); \
                    p0_ += g4[0] * wg0[4 * r4] + g4[1] * wg0[4 * r4 + 1] + g4[2] * wg0[4 * r4 + 2] + g4[3] * wg0[4 * r4 + 3]; p1_ += g4[0] * wg1[4 * r4] + g4[1] * wg1[4 * r4 + 1] + g4[2] * wg1[4 * r4 + 2] + g4[3] * wg1[4 * r4 + 3]; } \
                o0_ = (fminf(p0_, 0.f) - __logf(1.0f + __expf(-fabsf(p0_)))) * (1.0f / 16.0f); o1_ = (fminf(p1_, 0.f) - __logf(1.0f + __expf(-fabsf(p1_)))) * (1.0f / 16.0f); } while (0)
            float tot0 = 0.f, tot1 = 0.f;
#pragma unroll 16
            for (int j = 0; j < 64; ++j) { float a0, a1; GLA_GATE(j, a0, a1); tot0 += a0; tot1 += a1; }
            float run0 = 0.f, run1 = 0.f;
            u32x4* dst0 = (u32x4*)(KDTg + (((size_t)dir * 144 + gc) * 512 + col) * 64); u32x4* dst1 = dst0 + 8;
            for (int q8 = 0; q8 < 8; ++q8) { unsigned kd0[4], kd1[4];
#pragma unroll
                for (int j2 = 0; j2 < 4; ++j2) { float kv0[2], kv1[2];
#pragma unroll
                    for (int e = 0; e < 2; ++e) { const int j = 8 * q8 + 2 * j2 + e; const size_t m = m0 + j; float g0, g1; GLA_GATE(j, g0, g1);
                        const float b0 = dir == 0 ? run0 + g0 : tot0 - run0, b1 = dir == 0 ? run1 + g1 : tot1 - run1; run0 += g0; run1 += g1;
                        const unsigned qq = *(const unsigned*)(Y + m * YW + Y_GQ + col), kk = *(const unsigned*)(Y + m * YW + Y_GK + col);
                        *(unsigned*)(QEg + ((size_t)dir * MROWS + m) * 512 + col) = cvt_pk_bf16(lo_bf(qq) * __expf(b0), hi_bf(qq) * __expf(b1));
                        *(unsigned*)(KEg + ((size_t)dir * MROWS + m) * 512 + col) = cvt_pk_bf16(lo_bf(kk) * __expf(-b0), hi_bf(kk) * __expf(-b1));
                        kv0[e] = lo_bf(kk) * __expf(tot0 - b0); kv1[e] = hi_bf(kk) * __expf(tot1 - b1); }
                    kd0[j2] = cvt_pk_bf16(kv0[0], kv0[1]); kd1[j2] = cvt_pk_bf16(kv1[0], kv1[1]); }
                dst0[q8] = (u32x4){kd0[0], kd0[1], kd0[2], kd0[3]}; dst1[q8] = (u32x4){kd1[0], kd1[1], kd1[2], kd1[3]}; }
#undef GLA_GATE
            *(f32x2*)(DECg + ((size_t)dir * 144 + gc) * 512 + col) = (f32x2){__expf(tot0), __expf(tot1)};
        } else {
            const int rem = it - 1152, gc = rem >> 3, v = (rem & 7) * 128 + 2 * lane; const size_t m0 = (size_t)gc * 64;
            unsigned v0[32], v1[32];
#pragma unroll
            for (int j2 = 0; j2 < 32; ++j2) { const unsigned a0 = *(const unsigned*)(Y + (m0 + 2 * j2) * YW + Y_GV + v), a1 = *(const unsigned*)(Y + (m0 + 2 * j2 + 1) * YW + Y_GV + v);
                v0[j2] = (a0 & 0xffffu) | (a1 << 16); v1[j2] = (a0 >> 16) | (a1 & 0xffff0000u); }
            u32x4* dst = (u32x4*)(VTg + ((size_t)gc * 1024 + v) * 64);
#pragma unroll
            for (int q8 = 0; q8 < 8; ++q8) { dst[q8] = (u32x4){v0[4 * q8], v0[4 * q8 + 1], v0[4 * q8 + 2], v0[4 * q8 + 3]}; dst[8 + q8] = (u32x4){v1[4 * q8], v1[4 * q8 + 1], v1[4 * q8 + 2], v1[4 * q8 + 3]}; }
        }
    }
}
__device__ __forceinline__ bf16x8 ldsfrag(const LAS bf16_t* base, int row, int ld, int k) { return *(const LAS bf16x8*)(base + row * ld + k); }
__device__ __forceinline__ void gla_chain(const Args& a, int l, int chain, LAS unsigned char* lds) {
    const int tid = opaque(threadIdx.x), wave = __builtin_amdgcn_readfirstlane(tid >> 6), lane = tid & 63, r32 = lane & 31, hh = lane >> 5;
    const int vs = chain & 7, dir = (chain >> 3) & 1, h = (chain >> 4) & 3, b = chain >> 6;
    const bf16_t* QEg = (const bf16_t*)(a.ws + WS_QE) + (size_t)dir * MROWS * 512 + h * 128; const bf16_t* KEg = (const bf16_t*)(a.ws + WS_KE) + (size_t)dir * MROWS * 512 + h * 128;
    const bf16_t* KDTg = (const bf16_t*)(a.ws + WS_KDT) + ((size_t)dir * 144 * 512 + h * 128) * 64; const bf16_t* VTg = (const bf16_t*)(a.ws + WS_VT) + (size_t)(h * 256 + vs * 32) * 64;
    const float* DECg = (const float*)(a.ws + WS_DEC) + (size_t)dir * 144 * 512 + h * 128;
    float* OG = (float*)(a.ws + (dir ? WS_OGB : WS_OGF));
    LAS bf16_t* QE = (LAS bf16_t*)lds; LAS bf16_t* KE = QE + 64 * 136; LAS bf16_t* KDT = KE + 64 * 136; LAS bf16_t* VT = KDT + 128 * 72; LAS bf16_t* ATT = VT + 32 * 72; LAS bf16_t* ST = ATT + 64 * 72;
    LAS float* DEC = (LAS float*)(ST + 32 * 136);
    for (int i = tid; i < 32 * 136; i += NWAVES * 64) ST[i] = 0;
    f32x16 accS = {}, accO = {};
    const unsigned qsrc0 = (unsigned)((tid >> 4) * 512 + (tid & 15) * 8), qdst0 = (unsigned)((tid >> 4) * 136 + (tid & 15) * 8);
    const unsigned ksrc0 = (unsigned)((tid >> 3) * 64 + (tid & 7) * 8), kdst0 = (unsigned)((tid >> 3) * 72 + (tid & 7) * 8);
    u32x4 pq0, pq1, pk0, pk1, pd0, pd1, pv; float pdec = 0.f;
#define GLA_LOAD(ci_) do { const int ci__ = (ci_); const int c_ = dir == 0 ? ci__ : (ci__ < 4 ? 3 - ci__ : 39 - ci__); const int gc_ = b * 36 + c_; const size_t mr_ = (size_t)gc_ * 64; \
        pq0 = *(const u32x4*)(QEg + mr_ * 512 + qsrc0); pq1 = *(const u32x4*)(QEg + (mr_ + 32) * 512 + qsrc0); pk0 = *(const u32x4*)(KEg + mr_ * 512 + qsrc0); pk1 = *(const u32x4*)(KEg + (mr_ + 32) * 512 + qsrc0); \
        pd0 = *(const u32x4*)(KDTg + (size_t)gc_ * 512 * 64 + ksrc0); pd1 = *(const u32x4*)(KDTg + (size_t)gc_ * 512 * 64 + 64 * 64 + ksrc0); \
        if (tid < 256) pv = *(const u32x4*)(VTg + (size_t)gc_ * 1024 * 64 + ksrc0); if (tid < 128) pdec = DECg[(size_t)gc_ * 512 + tid]; } while (0)
    GLA_LOAD(0);
    __syncthreads();
    for (int ci = 0; ci < 36; ++ci) {
        const int c = dir == 0 ? ci : (ci < 4 ? 3 - ci : 39 - ci);
        const size_t mrow = ((size_t)b * 36 + c) * 64;
        *(LAS u32x4*)(QE + qdst0) = pq0; *(LAS u32x4*)(QE + 32 * 136 + qdst0) = pq1; *(LAS u32x4*)(KE + qdst0) = pk0; *(LAS u32x4*)(KE + 32 * 136 + qdst0) = pk1;
        *(LAS u32x4*)(KDT + kdst0) = pd0; *(LAS u32x4*)(KDT + 64 * 72 + kdst0) = pd1; if (tid < 256) *(LAS u32x4*)(VT + kdst0) = pv; if (tid < 128) DEC[tid] = pdec;
        __syncthreads();
        if (ci + 1 < 36) GLA_LOAD(ci + 1);
        if (wave < 4) {
            const int ib = wave >> 1, jb = wave & 1; f32x16 p = {};
            if ((dir == 0 && ib >= jb) || (dir == 1 && ib <= jb)) {
#pragma unroll
                for (int s = 0; s < 8; ++s) p = __builtin_amdgcn_mfma_f32_32x32x16_bf16(ldsfrag(QE, 32 * ib + r32, 136, 16 * s + 8 * hh), ldsfrag(KE, 32 * jb + r32, 136, 16 * s + 8 * hh), p, 0, 0, 0);
            }
#pragma unroll
            for (int rg = 0; rg < 16; ++rg) { const int i = 32 * ib + att::crow(rg, hh), j = 32 * jb + r32; const bool keep = dir == 0 ? (i >= j) : (i <= j); ATT[i * 72 + j] = f2bf(keep ? p[rg] : 0.f); }
        } else if (wave < 6) {
            const int ib = wave - 4; accO = (f32x16){};
#pragma unroll
            for (int s = 0; s < 8; ++s) accO = __builtin_amdgcn_mfma_f32_32x32x16_bf16(ldsfrag(QE, 32 * ib + r32, 136, 16 * s + 8 * hh), ldsfrag(ST, r32, 136, 16 * s + 8 * hh), accO, 0, 0, 0);
        }
        __syncthreads();
        if (wave < 4) {
            const int db = wave; const float dec = DEC[32 * db + r32];
#pragma unroll
            for (int rg = 0; rg < 16; ++rg) accS[rg] *= dec;
#pragma unroll
            for (int s = 0; s < 4; ++s) accS = __builtin_amdgcn_mfma_f32_32x32x16_bf16(ldsfrag(VT, r32, 72, 16 * s + 8 * hh), ldsfrag(KDT, 32 * db + r32, 72, 16 * s + 8 * hh), accS, 0, 0, 0);
#pragma unroll
            for (int rg = 0; rg < 16; ++rg) ST[att::crow(rg, hh) * 136 + 32 * db + r32] = f2bf(accS[rg]);
        } else if (wave < 6) {
            const int ib = wave - 4;
#pragma unroll
            for (int s = 0; s < 4; ++s) accO = __builtin_amdgcn_mfma_f32_32x32x16_bf16(ldsfrag(ATT, 32 * ib + r32, 72, 16 * s + 8 * hh), ldsfrag(VT, r32, 72, 16 * s + 8 * hh), accO, 0, 0, 0);
#pragma unroll
            for (int rg = 0; rg < 16; ++rg) { const int i = 32 * ib + att::crow(rg, hh); OG[(mrow + i) * 1024 + h * 256 + vs * 32 + r32] = accO[rg]; }
        }
        __syncthreads();
    }
#undef GLA_LOAD
}
__device__ __forceinline__ void s5_chain(const Args& a, int l, int chain, LAS unsigned char* ldsw, int lane_in) {
    const int lane = opaque(lane_in);
    const int dir = chain & 1, g = (chain >> 1) % 48, b = chain / 96, base = (l * 2 + dir) * 48 + g;
    const bf16_t* Y = (const bf16_t*)(a.ws + WS_Y); float* YS = (float*)(a.ws + (dir ? WS_YSB : WS_YSF));
    const float* SA = (const float*)(a.ws + WS_S5A); const bf16_t* KB = (const bf16_t*)(a.ws + WS_S5KB) + (size_t)base * 128 * 16; const bf16_t* CT = (const bf16_t*)(a.ws + WS_S5CT) + (size_t)base * 16 * 128;
    LAS float* BU = (LAS float*)ldsw; LAS bf16_t* XS = (LAS bf16_t*)(ldsw + 16 * 132 * 4);
    const int lq = lane >> 4, lr = lane & 15;
    const float are = SA[2 * (base * 64 + lane)], aim = SA[2 * (base * 64 + lane) + 1];
    const bf16x8 zero8 = {0, 0, 0, 0, 0, 0, 0, 0};
    bf16x8 fb[8], fc[4];
#pragma unroll
    for (int q = 0; q < 8; ++q) fb[q] = (lq < 2) ? *(const bf16x8*)(KB + (16 * q + lr) * 16 + 8 * lq) : zero8;
#pragma unroll
    for (int s = 0; s < 4; ++s) fc[s] = *(const bf16x8*)(CT + lr * 128 + 32 * s + 8 * lq);
    float xr = 0.f, xi = 0.f;
    const bf16_t* up = Y + ((size_t)b * TOK + lr) * YW + Y_SU + g * 16 + 8 * (lq & 1);
#define S5_TB(bi_) (dir == 0 ? (bi_) : ((bi_) < 16 ? 15 - (bi_) : 143 - ((bi_) - 16)))
    bf16x8 un = *(const bf16x8*)(up + (size_t)S5_TB(0) * 16 * YW);
    for (int bi = 0; bi < 144; ++bi) {
        const int tb = S5_TB(bi);
        const size_t row0 = (size_t)b * TOK + tb * 16;
        const bf16x8 ua = (lq < 2) ? un : zero8;
        if (bi + 1 < 144) un = *(const bf16x8*)(up + (size_t)S5_TB(bi + 1) * 16 * YW);
#pragma unroll
        for (int q = 0; q < 8; ++q) { const f32x4 r = __builtin_amdgcn_mfma_f32_16x16x32_bf16(ua, fb[q], (f32x4){0.f, 0.f, 0.f, 0.f}, 0, 0, 0);
#pragma unroll
            for (int rg = 0; rg < 4; ++rg) BU[(4 * lq + rg) * 132 + 16 * q + lr] = r[rg]; }
        LDS_WAIT();
#pragma unroll
        for (int st = 0; st < 16; ++st) { const int t = dir ? 15 - st : st;
            const float bre = BU[t * 132 + lane], bim = BU[t * 132 + 64 + lane];
            const float nr = are * xr - aim * xi + bre, ni = are * xi + aim * xr + bim; xr = nr; xi = ni;
            XS[t * 136 + lane] = f2bf(xr); XS[t * 136 + 64 + lane] = f2bf(xi); }
        LDS_WAIT();
        f32x4 yo = {0.f, 0.f, 0.f, 0.f};
#pragma unroll
        for (int s = 0; s < 4; ++s) yo = __builtin_amdgcn_mfma_f32_16x16x32_bf16(*(const LAS bf16x8*)(XS + lr * 136 + 32 * s + 8 * lq), fc[s], yo, 0, 0, 0);
#pragma unroll
        for (int rg = 0; rg < 4; ++rg) YS[(row0 + 4 * lq + rg) * 768 + g * 16 + lr] = yo[rg];
        LDS_WAIT();
    }
#undef S5_TB
}
__device__ __forceinline__ void postmix_phase(const Args& a, int l) {
    const int tid_ = opaque(threadIdx.x), lane = tid_ & 63, wave = tid_ >> 6, gw = blockIdx.x * NWAVES + wave, NGW = gridDim.x * NWAVES;
    const bf16_t* Y = (const bf16_t*)(a.ws + WS_Y); bf16_t* OC = (bf16_t*)(a.ws + WS_OCAT); bf16_t* YG = (bf16_t*)(a.ws + WS_YG);
    const float* OGF = (const float*)(a.ws + WS_OGF); const float* OGB = (const float*)(a.ws + WS_OGB); const float* YSF = (const float*)(a.ws + WS_YSF); const float* YSB = (const float*)(a.ws + WS_YSB);
    for (int m = gw; m < MROWS; m += NGW) {
#pragma unroll
        for (int h = 0; h < 4; ++h) { const int col = h * 256 + lane * 4;
            f32x4 o = *(const f32x4*)(OGF + (size_t)m * 1024 + col) + *(const f32x4*)(OGB + (size_t)m * 1024 + col);
            const float mean = wave_sum((o[0] + o[1]) + (o[2] + o[3])) * (1.0f / 256.0f); o = o - mean;
            const float rstd = 1.0f / sqrtf(wave_sum((o[0] * o[0] + o[1] * o[1]) + (o[2] * o[2] + o[3] * o[3])) * (1.0f / 256.0f) + LN_EPS);
            const f32x4 w = *(const f32x4*)(a.in[I_GLANW] + l * 1024 + col); const u32x2 gr = *(const u32x2*)(Y + (size_t)m * YW + Y_GR + col);
            o = o * rstd * w; u32x2 ov; ov.x = cvt_pk_bf16(o[0] * lo_bf(gr.x), o[1] * hi_bf(gr.x)); ov.y = cvt_pk_bf16(o[2] * lo_bf(gr.y), o[3] * hi_bf(gr.y));
            *(u32x2*)(OC + (size_t)m * OCW + col) = ov; }
#pragma unroll
        for (int j = 0; j < 3; ++j) { const int col = j * 256 + lane * 4;
            const u32x2 su = *(const u32x2*)(Y + (size_t)m * YW + Y_SU + col); const f32x4 dsk = *(const f32x4*)(a.in[I_S5D] + l * 768 + col);
            f32x4 y = *(const f32x4*)(YSF + (size_t)m * 768 + col) + *(const f32x4*)(YSB + (size_t)m * 768 + col);
#if defined(ABL) && ABL == 3
            y = (f32x4){0.f, 0.f, 0.f, 0.f};
#endif
            y[0] += lo_bf(su.x) * dsk[0]; y[1] += hi_bf(su.x) * dsk[1]; y[2] += lo_bf(su.y) * dsk[2]; y[3] += hi_bf(su.y) * dsk[3];
            u32x2 ov; ov.x = cvt_pk_bf16(fgelu_tanh(y[0]), fgelu_tanh(y[1])); ov.y = cvt_pk_bf16(fgelu_tanh(y[2]), fgelu_tanh(y[3]));
            *(u32x2*)(YG + (size_t)m * 768 + col) = ov; }
    }
}
#ifdef DIAG
constexpr size_t WS_DIAG = 512 * 1024;
__device__ __forceinline__ void diag_max(const Args& a, int k, float err) { if (!(err >= 0.f)) err = 9e9f; atomicMax((unsigned*)(a.ws + WS_DIAG) + k, __float_as_uint(err)); }
__device__ __forceinline__ unsigned dhash(unsigned x) { x ^= x >> 16; x *= 0x7feb352dU; x ^= x >> 15; x *= 0x846ca68bU; x ^= x >> 16; return x; }
__device__ __forceinline__ double ddot(const bf16_t* A, const bf16_t* B, int K) { double s = 0; for (int k = 0; k < K; ++k) s += (double)bf2f(A[k]) * (double)bf2f(B[k]); return s; }
__device__ __forceinline__ float relerr(float got, float ref, float floor_) { return fabsf(got - ref) / (fabsf(ref) + floor_); }
#define DIAG_NS 2048
#ifndef GLA_CHK_HI
#define GLA_CHK_HI 100000
#endif
#ifndef GLA_CHK_LO
#define GLA_CHK_LO 0
#endif
#ifndef GLA_CHK_DIR
#define GLA_CHK_DIR -1
#endif
#ifndef DIAG_LIMIT
#define DIAG_LIMIT 0.04f
#endif
#ifndef DIAG_LAYER
#define DIAG_LAYER 0
#endif
__device__ __forceinline__ void diag_check(const Args& a, int l, int which) {
    const int gt = blockIdx.x * (NWAVES * 64) + opaque(threadIdx.x), NT = gridDim.x * NWAVES * 64;
    unsigned char* ws = a.ws; unsigned char* wl = ws + WS_W + (size_t)l * WL_STRIDE;
    const bf16_t* H = (const bf16_t*)(ws + WS_H); const bf16_t* Y = (const bf16_t*)(ws + WS_Y); const float* GLR = (const float*)(ws + WS_GLR);
    const bf16_t* OC = (const bf16_t*)(ws + WS_OCAT); const bf16_t* YG = (const bf16_t*)(ws + WS_YG); const float* X = (const float*)(ws + WS_X); const float* Z = (const float*)(ws + WS_Z);
    const float* MOD = (const float*)(ws + WS_MOD) + (size_t)l * 5 * NMOD;
    if (which == 1) {
        const bf16_t* W = (const bf16_t*)(wl + WL_IN);
        for (int s = gt; s < DIAG_NS; s += NT) { const unsigned hx = dhash(s * 2654435761u + 17u); const int row = hx % MROWS; int n = (hx >> 13) % 11536; if ((s & 15) == 0) n = 11520 + (hx >> 9) % 16;
            const float d = (float)ddot(H + (size_t)row * DM, W + (size_t)n * DM, DM); float got; float ref = d;
            if (n >= 11520) got = GLR[(size_t)row * 16 + (n - 11520)];
            else { got = bf2f(Y[(size_t)row * YW + n]); if (n < 512) ref = d * 0.08838834764831845f; else if (n >= 2048 && n < 3072) ref = d / (1.0f + expf(-(float)d)); else if (n >= 5376) ref = 1.0f / (1.0f + expf(-(float)d)); }
            diag_max(a, 1, relerr(got, ref, 0.05f)); }
    }
    if (which == 2) {
        const float* OGF = (const float*)(ws + WS_OGF); const float* OGB = (const float*)(ws + WS_OGB); const float* YSF = (const float*)(ws + WS_YSF); const float* YSB = (const float*)(ws + WS_YSB);
        for (int s = gt; s < DIAG_NS; s += NT) { const unsigned hx = dhash(s * 2654435761u + 29u); const int row = hx % MROWS, c = (hx >> 14) % 1024, h = c >> 8;
            float mu = 0, var = 0; for (int v = 0; v < 256; ++v) mu += OGF[(size_t)row * 1024 + h * 256 + v] + OGB[(size_t)row * 1024 + h * 256 + v]; mu /= 256;
            for (int v = 0; v < 256; ++v) { const float o = OGF[(size_t)row * 1024 + h * 256 + v] + OGB[(size_t)row * 1024 + h * 256 + v] - mu; var += o * o; } var /= 256;
            const float o = OGF[(size_t)row * 1024 + c] + OGB[(size_t)row * 1024 + c];
            const float ref = (o - mu) / sqrtf((float)(var + 1e-6)) * a.in[I_GLANW][l * 1024 + c] * bf2f(Y[(size_t)row * YW + Y_GR + c]);
            diag_max(a, 2, relerr(bf2f(OC[(size_t)row * OCW + c]), ref, 0.05f));
            const int c2 = (hx >> 10) % 768; float y = YSF[(size_t)row * 768 + c2] + YSB[(size_t)row * 768 + c2] + bf2f(Y[(size_t)row * YW + Y_SU + c2]) * a.in[I_S5D][l * 768 + c2];
            const float g = 0.5f * y * (1.0f + tanhf((float)(0.7978845608028654f * (y + 0.044715f * y * y * y))));
            diag_max(a, 2, relerr(bf2f(YG[(size_t)row * 768 + c2]), g, 0.05f)); }
    }
    if (which == 3) {
        const bf16_t* W = (const bf16_t*)(wl + WL_GLU);
        for (int s = gt; s < DIAG_NS; s += NT) { const unsigned hx = dhash(s * 2654435761u + 31u); const int row = hx % MROWS, c = (hx >> 14) % 768;
            const float d = (float)ddot(YG + (size_t)row * 768, W + (size_t)c * 768, 768); const float ref = bf2f(YG[(size_t)row * 768 + c]) / (1.0f + expf(-(float)d));
            diag_max(a, 3, relerr(bf2f(OC[(size_t)row * OCW + 1024 + c]), ref, 0.03f)); }
    }
    if (which == 4) {
        const bf16_t* W = (const bf16_t*)(wl + WL_CAT);
        for (int s = gt; s < DIAG_NS; s += NT) { const unsigned hx = dhash(s * 2654435761u + 37u); const int row = hx % MROWS, c = (hx >> 14) % DM;
            const float pa = (float)ddot(OC + (size_t)row * OCW, W + (size_t)c * OCW, 1024), pb = (float)ddot(OC + (size_t)row * OCW + 1024, W + (size_t)c * OCW + 1024, 768), pc = (float)ddot(OC + (size_t)row * OCW + 1792, W + (size_t)c * OCW + 1792, 1024);
            const float ref = pa * bf2f(Y[(size_t)row * YW + Y_BG + c]) + pb * bf2f(Y[(size_t)row * YW + Y_BG + 2048 + c]) + pc * bf2f(Y[(size_t)row * YW + Y_BG + 4096 + c]);
            diag_max(a, 4, relerr(bf2f(H[(size_t)row * DM + c]), ref, 0.03f)); }
    }
    if (which == 5 || which == 8) {
        const bool ffn = which == 8; const bf16_t* W = (const bf16_t*)(wl + (ffn ? WL_FFO : WL_OUT)); const bf16_t* A = ffn ? Y : H; const int K = ffn ? DFF : DM;
        for (int s = gt; s < DIAG_NS; s += NT) { const unsigned hx = dhash(s * 2654435761u + 41u); const int row = hx % MROWS, c = (hx >> 14) % DM; const int t = row % TOK, cond = t < NCTX ? 4 : row / TOK;
            const float d = (float)ddot(A + (size_t)row * K, W + (size_t)c * K, K); const float ref = DN_ALPHA * X[(size_t)row * DM + c] + MOD[(size_t)cond * NMOD + (ffn ? 5 : 2) * DM + c] * d;
            diag_max(a, which, relerr(Z[(size_t)row * DM + c], ref, 0.02f)); }
    }
    if (which == 6 || which == 9) {
        const bool second = which == 9; const float* lw = a.in[second ? I_LN2W : I_LN1W] + l * DM; const float* lb = a.in[second ? I_LN2B : I_LN1B] + l * DM;
        const float* mp = second ? (const float*)(ws + WS_MOD) + (size_t)(l + 1) * 5 * NMOD : MOD + 3 * DM;
        for (int s = gt; s < 256; s += NT) { const unsigned hx = dhash(s * 2654435761u + 43u); const int row = hx % MROWS, c = (hx >> 14) % DM; const int t = row % TOK, cond = t < NCTX ? 4 : row / TOK;
            float mu = 0, var = 0; for (int k = 0; k < DM; ++k) mu += Z[(size_t)row * DM + k]; mu /= DM; for (int k = 0; k < DM; ++k) { const float dd = Z[(size_t)row * DM + k] - mu; var += dd * dd; } var /= DM;
            const float xn = (Z[(size_t)row * DM + c] - mu) / sqrtf((float)(var + 1e-6)) * lw[c] + lb[c];
            diag_max(a, which, relerr(X[(size_t)row * DM + c], xn, 0.02f));
            if (!(second && l + 1 == DEPTH)) { const float hh = xn * (1.0f + mp[(size_t)cond * NMOD + DM + c]) + mp[(size_t)cond * NMOD + c]; diag_max(a, which, relerr(bf2f(H[(size_t)row * DM + c]), hh, 0.03f)); } }
    }
    if (which == 7) {
        const bf16_t* W = (const bf16_t*)(wl + WL_FFI);
        for (int s = gt; s < DIAG_NS; s += NT) { const unsigned hx = dhash(s * 2654435761u + 47u); const int row = hx % MROWS, j = (hx >> 14) % DFF; const int na = (j >> 7) * 256 + (j & 127), nb = na + 128;
            const float da = (float)ddot(H + (size_t)row * DM, W + (size_t)na * DM, DM), db = (float)ddot(H + (size_t)row * DM, W + (size_t)nb * DM, DM); const float ref = da / (1.0f + expf(-(float)da)) * db;
            diag_max(a, 7, relerr(bf2f(Y[(size_t)row * DFF + j]), ref, 0.03f)); }
    }
}
__device__ __forceinline__ void diag_report(const Args& a) {
    if (blockIdx.x == 0 && threadIdx.x == 0) { const unsigned* d = (const unsigned*)(a.ws + WS_DIAG); float code = 0.f;
        for (int k = 1; k <= 9; ++k) { const float e = __uint_as_float(__hip_atomic_load(d + k, __ATOMIC_RELAXED, __HIP_MEMORY_SCOPE_AGENT)); if (e > DIAG_LIMIT) { int lvl = (int)(e * 20.f); lvl = lvl > 9 ? 9 : lvl; code = (float)((10 * k + lvl) * 100); break; } }
        if (code > 0.f) a.out[0] = code; }
}
#endif
#ifdef DIAG
__device__ __forceinline__ void diag_check2(const Args& a, int l, int which) {
    const int tid = opaque(threadIdx.x), lane = tid & 63, gwv = blockIdx.x * NWAVES + (tid >> 6), gt = blockIdx.x * (NWAVES * 64) + tid, NT = gridDim.x * NWAVES * 64;
    unsigned char* ws = a.ws; const bf16_t* Y = (const bf16_t*)(ws + WS_Y);
    if (which == 1) {
        const float* MOD = (const float*)(ws + WS_MOD);
        for (int s = gt; s < 1024; s += NT) { const unsigned hx = dhash(s * 2654435761u + 53u); const int ll = hx & 3, r = (hx >> 2) % 5, n = (hx >> 8) % NMOD; float acc = a.in[I_BADA][ll * NMOD + n];
            for (int k = 0; k < DM; ++k) { const float v = r < 4 ? a.in[I_C][r * DM + k] : a.in[I_CCTX][k]; acc += (v / (1.0f + expf(-v))) * a.in[I_WADA][((size_t)ll * DM + k) * NMOD + n]; }
            diag_max(a, 1, relerr(MOD[((size_t)ll * 5 + r) * NMOD + n], (float)acc, 0.01f)); }
    }
    if (which == 2) {
        for (int s = gt; s < 8192; s += NT) { const unsigned hx = dhash(s * 2654435761u + 59u); const int ll = hx & 3, mat = (hx >> 2) % 8; const unsigned h2 = dhash(hx); unsigned char* wl = ws + WS_W + (size_t)ll * WL_STRIDE;
            float src = 0.f; bf16_t got = 0;
            if (mat == 0) { const int n = h2 % NIN, k = (h2 >> 14) % DM; const int sc = map_col<1>(n); src = sc >= 0 ? a.in[I_WIN][((size_t)ll * DM + k) * 11536 + sc] : 0.f; got = ((const bf16_t*)(wl + WL_IN))[(size_t)n * DM + k]; }
            else if (mat == 1) { const int n = h2 % 768, k = (h2 >> 14) % 768; src = a.in[I_WGLU][((size_t)ll * 768 + k) * 768 + n]; got = ((const bf16_t*)(wl + WL_GLU))[(size_t)n * 768 + k]; }
            else if (mat == 2) { const int n = h2 % DM, k = (h2 >> 14) % 1024; src = a.in[I_WPG][((size_t)ll * 1024 + k) * DM + n]; got = ((const bf16_t*)(wl + WL_CAT))[(size_t)n * OCW + k]; }
            else if (mat == 3) { const int n = h2 % DM, k = (h2 >> 14) % 768; src = a.in[I_WPS][((size_t)ll * 768 + k) * DM + n]; got = ((const bf16_t*)(wl + WL_CAT))[(size_t)n * OCW + 1024 + k]; }
            else if (mat == 4) { const int n = h2 % DM, k = (h2 >> 14) % 1024; src = a.in[I_WPA][((size_t)ll * 1024 + k) * DM + n]; got = ((const bf16_t*)(wl + WL_CAT))[(size_t)n * OCW + 1792 + k]; }
            else if (mat == 5) { const int n = h2 % DM, k = (h2 >> 14) % DM; src = a.in[I_WOUT][((size_t)ll * DM + k) * DM + n]; got = ((const bf16_t*)(wl + WL_OUT))[(size_t)n * DM + k]; }
            else if (mat == 6) { const int n = h2 % (2 * DFF), k = (h2 >> 14) % DM; src = a.in[I_WFFI][((size_t)ll * DM + k) * (2 * DFF) + map_col<2>(n)]; got = ((const bf16_t*)(wl + WL_FFI))[(size_t)n * DM + k]; }
            else { const int n = h2 % DM, k = (h2 >> 12) % DFF; src = a.in[I_WFFO][((size_t)ll * DFF + k) * DM + n]; got = ((const bf16_t*)(wl + WL_FFO))[(size_t)n * DFF + k]; }
            diag_max(a, 2, (got == f2bf(src)) ? 0.f : 1.f); }
    }
    if (which == 3) {
        const bf16_t* QN = (const bf16_t*)(ws + WS_QN); const bf16_t* KN = (const bf16_t*)(ws + WS_KN);
        for (int s = gt; s < 2048; s += NT) { const unsigned hx = dhash(s * 2654435761u + 61u); const int m = hx % MROWS, hh = (hx >> 14) % 10, e = (hx >> 18) % 128; const int t = m % TOK; const bool isq = hh < 8;
            const bf16_t* src = Y + (size_t)m * YW + (isq ? Y_AQ + hh * 128 : Y_AK + (hh - 8) * 128); const float* w = a.in[isq ? I_QNW : I_KNW] + l * 128;
            float ss = 0.f; for (int i = 0; i < 128; ++i) { const float x = bf2f(src[i]); ss += x * x; } const float rstd = 1.0f / sqrtf(ss / 128.0f + 1e-6f);
            const int pi = e >> 1; const float x0 = bf2f(src[2 * pi]) * rstd * w[2 * pi], x1 = bf2f(src[2 * pi + 1]) * rstd * w[2 * pi + 1]; float ref;
            if (t >= NCTX) { const int sl = t - NCTX; const float pos = pi < 32 ? (float)(sl / 64) : (float)(sl % 64); const float ang = pos * powf(10000.0f, -(float)(pi & 31) / 32.0f); ref = (e & 1) ? x0 * sinf(ang) + x1 * cosf(ang) : x0 * cosf(ang) - x1 * sinf(ang); }
            else ref = (e & 1) ? x1 : x0;
            const float got = bf2f(isq ? QN[(size_t)m * 1024 + hh * 128 + e] : KN[(size_t)m * 256 + (hh - 8) * 128 + e]);
            diag_max(a, 3, relerr(got, ref, 0.05f)); }
    }
    if (which == 4) {
        const bf16_t* QN = (const bf16_t*)(ws + WS_QN); const bf16_t* KN = (const bf16_t*)(ws + WS_KN); const bf16_t* OC = (const bf16_t*)(ws + WS_OCAT);
        for (int s = gwv; s < 96; s += gridDim.x * NWAVES) { const unsigned hx = dhash(s * 2654435761u + 67u); int m = hx % MROWS; if (s < 16) m = (m / TOK) * TOK + (m % NCTX); const int h = (hx >> 14) & 7, kvh = h >> 2; const int t = m % TOK, b = m / TOK;
            const int nk = t < NCTX ? NCTX : TOK; const size_t kr0 = (size_t)b * TOK; float sc[36]; float mx = -1e30f;
#pragma unroll
            for (int i = 0; i < 36; ++i) { const int j = lane + 64 * i; float d = -1e30f; if (j < nk) { d = 0.f; for (int e = 0; e < 128; ++e) d += bf2f(QN[(size_t)m * 1024 + h * 128 + e]) * bf2f(KN[(kr0 + j) * 256 + kvh * 128 + e]); d *= 0.08838834764831845f; } sc[i] = d; mx = fmaxf(mx, d); }
#pragma unroll
            for (int o = 1; o < 64; o <<= 1) mx = fmaxf(mx, __shfl_xor(mx, o));
            float sum = 0.f;
#pragma unroll
            for (int i = 0; i < 36; ++i) { sc[i] = (lane + 64 * i < nk) ? expf(sc[i] - mx) : 0.f; sum += sc[i]; }
            sum = wave_sum(sum); float worst = 0.f;
            for (int e = 0; e < 128; ++e) { float acc = 0.f;
#pragma unroll
                for (int i = 0; i < 36; ++i) { const int j = lane + 64 * i; if (j < nk) acc += sc[i] * bf2f(Y[(kr0 + j) * YW + Y_AV + kvh * 128 + e]); }
                acc = wave_sum(acc) / sum; worst = fmaxf(worst, relerr(bf2f(OC[(size_t)m * OCW + 1792 + h * 128 + e]), acc, 0.03f)); }
            if (lane == 0) diag_max(a, 4, worst); }
    }
    if (which == 5) {
        for (int s = gwv; s < 24; s += gridDim.x * NWAVES) { const unsigned hx = dhash(s * 2654435761u + 71u); const int dir = s & 1, g = (hx >> 3) % 48, b = (hx >> 12) & 3, base = (l * 2 + dir) * 48 + g;
            const float* YS = (const float*)(ws + (dir ? WS_YSB : WS_YSF));
            const float lre = a.in[I_LAMRE][base * 64 + lane], lim = a.in[I_LAMIM][base * 64 + lane], dt = expf(a.in[I_LOGDT][base]);
            const float mag = expf(lre * dt), ared = mag * cosf(lim * dt), aimd = mag * sinf(lim * dt), den = lre * lre + lim * lim, nr = ared - 1.0f, ni = aimd; const float kre = ((nr * lre + ni * lim) / den), kim = ((ni * lre - nr * lim) / den), are = ared, aim = aimd;
            const float* bre = a.in[I_BRE] + ((size_t)(l * 48 + g) * 64 + lane) * 16; const float* bim = a.in[I_BIM] + ((size_t)(l * 48 + g) * 64 + lane) * 16;
            float xr = 0.f, xi = 0.f, sd = 0.f, sr = 0.f;
            for (int st = 0; st < TOK; ++st) { const int t = dir == 0 ? st : (st < NCTX ? NCTX - 1 - st : TOK - 1 - (st - NCTX)); const size_t m = (size_t)b * TOK + t;
                float ur = 0.f, ui = 0.f; for (int c = 0; c < 16; ++c) { const float u = bf2f(Y[m * YW + Y_SU + g * 16 + c]); ur += bre[c] * u; ui += bim[c] * u; }
                const float inr = kre * ur - kim * ui, ini = kre * ui + kim * ur; const float n0 = are * xr - aim * xi + inr, n1 = are * xi + aim * xr + ini; xr = n0; xi = n1;
                if ((st & 7) == 3 || st == NCTX || st == TOK - 1) { for (int c = 0; c < 16; ++c) { const size_t ci = ((size_t)base * 16 + c) * 64 + lane; const float y = wave_sum(a.in[I_CRE][ci] * xr - a.in[I_CIM][ci] * xi); const float df = YS[m * 768 + g * 16 + c] - y; sd += df * df; sr += y * y; } } }
            if (lane == 0) diag_max(a, 5, sqrtf(sd / (sr + 1e-12f))); }
    }
    if (which == 6) {
        const float* GLR = (const float*)(ws + WS_GLR);
        for (int s = gwv; s < 24; s += gridDim.x * NWAVES) { const unsigned hx = dhash(s * 2654435761u + 73u); const int dir = s & 1, h = (hx >> 3) & 3, b = (hx >> 6) & 3, v = (hx >> 9) & 255;
            const float* OG = (const float*)(ws + (dir ? WS_OGB : WS_OGF)); float wg0[16], wg1[16];
#pragma unroll
            for (int r = 0; r < 16; ++r) { wg0[r] = a.in[I_WGATE][((size_t)(l * 2 + dir) * 16 + r) * 512 + h * 128 + 2 * lane]; wg1[r] = a.in[I_WGATE][((size_t)(l * 2 + dir) * 16 + r) * 512 + h * 128 + 2 * lane + 1]; }
            const float bg0 = a.in[I_BGATE][(l * 2 + dir) * 512 + h * 128 + 2 * lane], bg1 = a.in[I_BGATE][(l * 2 + dir) * 512 + h * 128 + 2 * lane + 1];
            float s0 = 0.f, s1 = 0.f, sd = 0.f, sr = 0.f;
            for (int st = 0; st < TOK; ++st) { const int t = dir == 0 ? st : (st < NCTX ? NCTX - 1 - st : TOK - 1 - (st - NCTX)); const size_t m = (size_t)b * TOK + t;
                float p0 = bg0, p1 = bg1;
#pragma unroll
                for (int r = 0; r < 16; ++r) { const float gl = GLR[m * 16 + r]; p0 += gl * wg0[r]; p1 += gl * wg1[r]; }
                const float a0 = expf((fminf(p0, 0.f) - log1pf(expf(-fabsf(p0)))) / 16.0f), a1 = expf((fminf(p1, 0.f) - log1pf(expf(-fabsf(p1)))) / 16.0f);
                const float vv = bf2f(Y[m * YW + Y_GV + h * 256 + v]); const unsigned kq = *(const unsigned*)(Y + m * YW + Y_GK + h * 128 + 2 * lane), qq = *(const unsigned*)(Y + m * YW + Y_GQ + h * 128 + 2 * lane);
                s0 = a0 * s0 + lo_bf(kq) * vv; s1 = a1 * s1 + hi_bf(kq) * vv;
                const float o = wave_sum(lo_bf(qq) * s0 + hi_bf(qq) * s1);
                if (((st & 3) == 1 || st == NCTX) && st < GLA_CHK_HI && st >= GLA_CHK_LO && (GLA_CHK_DIR < 0 || dir == GLA_CHK_DIR)) { const float df = OG[m * 1024 + h * 256 + v] - o; sd += df * df; sr += o * o; } }
            if (lane == 0) diag_max(a, 6, sqrtf(sd / (sr + 1e-12f))); }
    }
}
#endif
__global__ void __launch_bounds__(NWAVES * 64, 2) fwd_kernel(Args args) {
    extern __shared__ __attribute__((aligned(16))) unsigned char lds_raw[];
    LAS unsigned char* lds = (LAS unsigned char*)lds_raw;
    const int tid = threadIdx.x, wave = __builtin_amdgcn_readfirstlane(tid >> 6), lane = tid & 63;
    const int G = gridDim.x;
    unsigned char* ws = args.ws;
    for (int u = tid; u < (LDS_BYTES - LDSCTL_OFF) / 4; u += NWAVES * 64) ((LAS unsigned*)(lds + LDSCTL_OFF))[u] = 0u;
    __syncthreads();
    const int lo = args.ph_lo, hi = args.ph_hi;
    XcdBarrier bar; bar.bar = (unsigned*)(ws + WS_CTL) + CW_BAR; bar.x = 0; bar.st = nullptr;
    if (hi - lo > 1) bar = xcd_barrier_post((unsigned*)(ws + WS_CTL) + CW_BAR, (volatile LAS unsigned*)(lds + MISC_OFF) + 8);
#ifndef PHMASK
#define PHMASK 0xFFFF
#endif
#define IN(k) (lo <= (k) && (k) < hi)
#ifndef PREPREP
#define PREPREP 0
#endif
#ifndef REPEAT_MASK
#define REPEAT_MASK 0
#endif
#define REPS(j) ((((REPEAT_MASK) >> (j)) & 1) ? 2 : 1)
#define INL(j) ((((PHMASK) >> (j)) & 1) && IN(pb + (j)))
#define INP(j) ((((PHMASK) >> (11 + (j))) & 1) && IN(j))
#define SEAM(k) do { if (IN((k) + 1)) xcd_barrier(bar); } while (0)
#ifdef DIAG
#ifndef DIAG_MASK
#define DIAG_MASK 0x3FE
#endif
#define DCHK(id) do { if (((DIAG_MASK) >> (id)) & 1) { if (l == DIAG_LAYER) { diag_check(pa, l, id); xcd_barrier(bar); } } } while (0)
#else
#define DCHK(id) do { } while (0)
#endif

    if (INP(0)) for (int rep_ = 0; rep_ < REPS(11); ++rep_) { p0_prologue(args, lds); SEAM(0); }
    if (INP(1)) for (int rep_ = 0; rep_ < REPS(12); ++rep_) { p1_mod(args); SEAM(1); }
    if (INP(2)) for (int rep_ = 0; rep_ < REPS(13); ++rep_) { p2_input(args); SEAM(2); }
#if defined(DIAG) && defined(DIAG2_MASK)
    if ((DIAG2_MASK >> 1) & 1) { diag_check2(args, 0, 1); xcd_barrier(bar); }
    if ((DIAG2_MASK >> 2) & 1) { diag_check2(args, 0, 2); xcd_barrier(bar); }
#endif

    for (int l = 0; l < DEPTH; ++l) {
        const int pb = NPH_PRO + l * NPH_LAYER;
#define PHASE_ENV unsigned char* ws = opaque_ptr(args.ws); Args pa = args; pa.ws = ws; unsigned char* wl = ws + WS_W + (size_t)l * WL_STRIDE; const float* MOD = (const float*)(ws + WS_MOD); const float* modl = MOD + (size_t)l * 5 * NMOD; (void)wl; (void)modl; (void)MOD
        if (INL(0)) for (int rep_ = 0; rep_ < REPS(0); ++rep_) { PHASE_ENV;
            pg8::Gemm g{(const bf16_t*)(ws + WS_H), (const bf16_t*)(wl + WL_IN), MROWS, NIN, DM, DM, DM}; pg8::StaticOrder S; S.init(MROWS, NIN, G, (int)blockIdx.x);
            pg8::EpiInProj E{(bf16_t*)(ws + WS_Y), (float*)(ws + WS_GLR)};
            pg8::gemm_phase<pg8::EpiInProj, pg8::StaticOrder, true, true>(lds, g, S, E);
            SEAM(pb + 0); DCHK(1);
        }
        if (INL(1)) for (int rep_ = 0; rep_ < REPS(1); ++rep_) { PHASE_ENV; for (int r3_ = 0; r3_ < ((PREPREP & 1) ? 2 : 1); ++r3_) qk_phase(pa, l); for (int r3_ = 0; r3_ < ((PREPREP & 2) ? 2 : 1); ++r3_) gla_prep_phase(pa, l); SEAM(pb + 1);
#if defined(DIAG) && defined(DIAG2_MASK)
            if (((DIAG2_MASK >> 3) & 1) && l == DIAG_LAYER) { diag_check2(pa, l, 3); xcd_barrier(bar); }
#endif
        }
        if (INL(2)) for (int rep_ = 0; rep_ < REPS(2); ++rep_) { PHASE_ENV;
            {
                unsigned* qhead = (unsigned*)(ws + WS_CTL) + CW_QUEUE + 64 * l;
                volatile LAS unsigned* qslot = (volatile LAS unsigned*)(lds + MISC_OFF) + 16;
                for (;;) {
                    if (tid == 0) qslot[0] = __hip_atomic_fetch_add(qhead, 1u, __ATOMIC_RELAXED, __HIP_MEMORY_SCOPE_AGENT);
                    __syncthreads();
                    const int item = (int)qslot[0];
                    __syncthreads();
                    if (item >= 592) break;
                    if (item < 48) { s5_chain(pa, l, item * 8 + wave, lds + wave * 12800, lane); __syncthreads(); }
                    else if (item < 304) attn_unit(pa, item - 48, (char*)lds_raw);
                    else if (item < 560) gla_chain(pa, l, item - 304, lds);
                    else attn_unit(pa, 256 + (item - 560), (char*)lds_raw);
                }
            }
            SEAM(pb + 2);
#if defined(DIAG) && defined(DIAG2_MASK)
            if (l == DIAG_LAYER) { if ((DIAG2_MASK >> 4) & 1) diag_check2(pa, l, 4); if ((DIAG2_MASK >> 5) & 1) diag_check2(pa, l, 5); if ((DIAG2_MASK >> 6) & 1) diag_check2(pa, l, 6); xcd_barrier(bar); }
#endif
        }
        if (INL(3)) for (int rep_ = 0; rep_ < REPS(3); ++rep_) { PHASE_ENV; postmix_phase(pa, l); SEAM(pb + 3); DCHK(2); }
        if (INL(4)) for (int rep_ = 0; rep_ < REPS(4); ++rep_) { PHASE_ENV;
            pg8::Gemm g{(const bf16_t*)(ws + WS_YG), (const bf16_t*)(wl + WL_GLU), MROWS, 768, 768, 768, 768}; pg8::StaticOrder S; S.init(MROWS, 768, G, (int)blockIdx.x);
            pg8::EpiGlu E{(const bf16_t*)(ws + WS_YG), (bf16_t*)(ws + WS_OCAT)};
            pg8::gemm_phase<pg8::EpiGlu, pg8::StaticOrder, true, true>(lds, g, S, E);
            SEAM(pb + 4); DCHK(3);
        }
        if (INL(5)) for (int rep_ = 0; rep_ < REPS(5); ++rep_) { PHASE_ENV;
            const bf16_t* OC = (const bf16_t*)(ws + WS_OCAT); const bf16_t* WC = (const bf16_t*)(wl + WL_CAT);
            pg8::StaticOrder S; S.init(MROWS, DM, G, (int)blockIdx.x);
            { pg8::Gemm g{OC, WC, MROWS, DM, 1024, OCW, OCW}; pg8::EpiMerge<0> E{(const bf16_t*)(ws + WS_Y), (float*)(ws + WS_Z), (bf16_t*)(ws + WS_H)};
              pg8::gemm_phase<pg8::EpiMerge<0>, pg8::StaticOrder, true, true>(lds, g, S, E); }
            { pg8::Gemm g{OC + 1024, WC + 1024, MROWS, DM, 768, OCW, OCW}; pg8::EpiMerge<1> E{(const bf16_t*)(ws + WS_Y), (float*)(ws + WS_Z), (bf16_t*)(ws + WS_H)};
              pg8::gemm_phase<pg8::EpiMerge<1>, pg8::StaticOrder, true, true>(lds, g, S, E); }
            { pg8::Gemm g{OC + 1792, WC + 1792, MROWS, DM, 1024, OCW, OCW}; pg8::EpiMerge<2> E{(const bf16_t*)(ws + WS_Y), (float*)(ws + WS_Z), (bf16_t*)(ws + WS_H)};
              pg8::gemm_phase<pg8::EpiMerge<2>, pg8::StaticOrder, true, true>(lds, g, S, E); }
            SEAM(pb + 5); DCHK(4);
        }
        if (INL(6)) for (int rep_ = 0; rep_ < REPS(6); ++rep_) { PHASE_ENV;
            pg8::Gemm g{(const bf16_t*)(ws + WS_H), (const bf16_t*)(wl + WL_OUT), MROWS, DM, DM, DM, DM}; pg8::StaticOrder S; S.init(MROWS, DM, G, (int)blockIdx.x);
            pg8::EpiResid E{(const float*)(ws + WS_X), (float*)(ws + WS_Z), modl + 2 * DM};
            pg8::gemm_phase<pg8::EpiResid, pg8::StaticOrder, true, true>(lds, g, S, E);
            SEAM(pb + 6); DCHK(5);
        }
        if (INL(7)) for (int rep_ = 0; rep_ < REPS(7); ++rep_) { PHASE_ENV; ln_phase(pa, pa.in[I_LN1W] + l * DM, pa.in[I_LN1B] + l * DM, modl + 3 * DM, nullptr); SEAM(pb + 7); DCHK(6); }
        if (INL(8)) for (int rep_ = 0; rep_ < REPS(8); ++rep_) { PHASE_ENV;
            pg8::Gemm g{(const bf16_t*)(ws + WS_H), (const bf16_t*)(wl + WL_FFI), MROWS, 2 * DFF, DM, DM, DM}; pg8::StaticOrder S; S.init(MROWS, 2 * DFF, G, (int)blockIdx.x);
            pg8::EpiSwiglu E{(bf16_t*)(ws + WS_Y)};
            pg8::gemm_phase<pg8::EpiSwiglu, pg8::StaticOrder, true, true>(lds, g, S, E);
            SEAM(pb + 8); DCHK(7);
        }
        if (INL(9)) for (int rep_ = 0; rep_ < REPS(9); ++rep_) { PHASE_ENV;
            pg8::Gemm g{(const bf16_t*)(ws + WS_Y), (const bf16_t*)(wl + WL_FFO), MROWS, DM, DFF, DFF, DFF}; pg8::StaticOrder S; S.init(MROWS, DM, G, (int)blockIdx.x);
            pg8::EpiResid E{(const float*)(ws + WS_X), (float*)(ws + WS_Z), modl + 5 * DM};
            pg8::gemm_phase<pg8::EpiResid, pg8::StaticOrder, true, true>(lds, g, S, E);
            SEAM(pb + 9); DCHK(8);
        }
        if (INL(10)) for (int rep_ = 0; rep_ < REPS(10); ++rep_) { PHASE_ENV;
            if (l + 1 < DEPTH) ln_phase(pa, pa.in[I_LN2W] + l * DM, pa.in[I_LN2B] + l * DM, MOD + (size_t)(l + 1) * 5 * NMOD, nullptr);
            else ln_phase(pa, pa.in[I_LN2W] + l * DM, pa.in[I_LN2B] + l * DM, nullptr, pa.out);
            SEAM(pb + 10);
#ifdef DIAG
            if ((DIAG_MASK >> 9) & 1) { if (l == DIAG_LAYER) { if (!IN(pb + 11)) xcd_barrier(bar); diag_check(pa, l, 9); xcd_barrier(bar); } }
#endif
        }
    }
#ifdef DIAG
    xcd_barrier(bar); diag_report(args);
#endif
#undef IN
#undef INL
#undef INP
#undef SEAM
}

#ifndef MK_MULTI_LAUNCH
#define MK_MULTI_LAUNCH 0
#endif
extern "C" void kernel_launch(void* const* d_in, const int* in_sizes, int n_in, void* d_out, int out_size, void* d_ws, size_t ws_size, hipStream_t stream) {
    static int grid = 0;
    if (grid == 0) {
        if (n_in != 31 || out_size != NB * SEQ * DM || ws_size < WS_END) { fprintf(stderr, "kernel_launch: unexpected shapes (n_in %d out %d ws %zu, need %zu)\n", n_in, out_size, ws_size, (size_t)WS_END); grid = -1; return; }
        int dev = 0, cus = 0, per_cu = 0;
        if (hipGetDevice(&dev) != hipSuccess || hipDeviceGetAttribute(&cus, hipDeviceAttributeMultiprocessorCount, dev) != hipSuccess) { grid = -1; return; }
        if (hipFuncSetAttribute((const void*)fwd_kernel, hipFuncAttributeMaxDynamicSharedMemorySize, LDS_BYTES) != hipSuccess) { fprintf(stderr, "kernel_launch: hipFuncSetAttribute failed\n"); grid = -1; return; }
        if (hipOccupancyMaxActiveBlocksPerMultiprocessor(&per_cu, (const void*)fwd_kernel, NWAVES * 64, LDS_BYTES) != hipSuccess || per_cu < 1) fprintf(stderr, "kernel_launch: occupancy query says %d\n", per_cu);
        (void)hipGetLastError();
        grid = cus;
    }
    if (grid < 0) return;
    (void)hipMemsetAsync((char*)d_ws + WS_CTL, 0, CTL_ZERO_BYTES, stream);
    Args a{};
    for (int i = 0; i < 31; ++i) a.in[i] = (const float*)d_in[i];
    a.out = (float*)d_out; a.ws = (unsigned char*)d_ws;
#if MK_MULTI_LAUNCH
    for (int p = 0; p < NPH_TOTAL; ++p) { a.ph_lo = p; a.ph_hi = p + 1; hipLaunchKernelGGL(fwd_kernel, dim3(grid), dim3(NWAVES * 64), LDS_BYTES, stream, a); }
#else
    a.ph_lo = 0; a.ph_hi = NPH_TOTAL; hipLaunchKernelGGL(fwd_kernel, dim3(grid), dim3(NWAVES * 64), LDS_BYTES, stream, a);
#endif
    const hipError_t le = hipPeekAtLastError();
    if (le != hipSuccess) fprintf(stderr, "kernel_launch: launch failed: %s\n", hipGetErrorName(le));
}
```

```cpp
#include <hip/hip_runtime.h>
#include <hip/hip_bf16.h>
#include <cstdio>
#include <cstdint>

#define LAS __attribute__((address_space(3)))
typedef unsigned short bf16_t;
typedef short bf16x8 __attribute__((ext_vector_type(8)));
typedef short s16x4 __attribute__((ext_vector_type(4)));
typedef float f32x4 __attribute__((ext_vector_type(4)));
typedef float f32x2 __attribute__((ext_vector_type(2)));
typedef float f32x8 __attribute__((ext_vector_type(8)));
typedef float f32x16 __attribute__((ext_vector_type(16)));
typedef unsigned u32x4 __attribute__((ext_vector_type(4)));
typedef unsigned u32x2 __attribute__((ext_vector_type(2)));

constexpr int DM = 2048, NB = 4, SEQ = 2048, NCTX = 256, TOK = NCTX + SEQ, MROWS = NB * TOK, DEPTH = 4;
constexpr int NIN = 11776;
constexpr int YW = 11520;
constexpr int Y_GQ = 0, Y_GK = 512, Y_GV = 1024, Y_GR = 2048, Y_SU = 3072, Y_AQ = 3840, Y_AK = 4864, Y_AV = 5120, Y_BG = 5376;
constexpr int DFF = 5632, OCW = 2816;
constexpr int NMOD = 6 * DM;
constexpr int ADA_KS = 32;
constexpr float DN_ALPHA = 1.6817928305074290f;
constexpr float LN_EPS = 1e-6f;

constexpr size_t MiB = 1u << 20;
constexpr size_t WS_CTL = 0, CTL_ZERO_BYTES = 1 * MiB;
constexpr size_t WS_MODP = 1 * MiB;
constexpr size_t WS_MOD = 32 * MiB;
constexpr size_t WS_S5A = 33 * MiB;
constexpr size_t WS_S5KB = 34 * MiB;
constexpr size_t WS_S5CT = 36 * MiB;
constexpr size_t WS_GLR = 38 * MiB;
constexpr size_t WS_X = 40 * MiB;
constexpr size_t WS_Z = 112 * MiB;
constexpr size_t WS_H = 184 * MiB;
constexpr size_t WS_Y = 220 * MiB;
constexpr size_t WS_QN = 423 * MiB;
constexpr size_t WS_KN = 441 * MiB;
constexpr size_t WS_OCAT = 446 * MiB;
constexpr size_t WS_OGF = 496 * MiB, WS_OGB = 532 * MiB;
constexpr size_t WS_YSF = 568 * MiB, WS_YSB = 595 * MiB;
constexpr size_t WS_YG = 622 * MiB;
constexpr size_t WS_W = 636 * MiB;
constexpr size_t WL_IN = 0, WL_GLU = 46 * MiB, WL_CAT = 48 * MiB, WL_OUT = 59 * MiB, WL_FFI = 67 * MiB, WL_FFO = 111 * MiB, WL_STRIDE = 133 * MiB;
constexpr size_t WS_QE = WS_W + 4 * WL_STRIDE;
constexpr size_t WS_KE = WS_QE + 18 * MiB;
constexpr size_t WS_KDT = WS_KE + 18 * MiB;
constexpr size_t WS_VT = WS_KDT + 18 * MiB;
constexpr size_t WS_DEC = WS_VT + 18 * MiB;
constexpr size_t WS_PART = WS_DEC + 1 * MiB;
constexpr size_t WS_T = WS_PART + 88 * MiB;
constexpr size_t WS_END = WS_T + 72 * MiB;

__device__ __forceinline__ float bf2f(bf16_t b) { return __uint_as_float(((unsigned)b) << 16); }
typedef __bf16 bf16x2n __attribute__((ext_vector_type(2)));
__device__ __forceinline__ unsigned cvt_pk_bf16(float lo, float hi) { const f32x2 v = {lo, hi}; return __builtin_bit_cast(unsigned, __builtin_convertvector(v, bf16x2n)); }
__device__ __forceinline__ bf16_t f2bf(float f) { return __builtin_bit_cast(unsigned short, (__bf16)f); }
__device__ __forceinline__ float lo_bf(unsigned w) { return __uint_as_float(w << 16); }
__device__ __forceinline__ float hi_bf(unsigned w) { return __uint_as_float(w & 0xffff0000u); }
__device__ __forceinline__ float fsigmoid(float x) { return 1.0f / (1.0f + __expf(-x)); }
__device__ __forceinline__ float fsilu(float x) { return x / (1.0f + __expf(-x)); }
__device__ __forceinline__ float flogsigmoid(float x) { return fminf(x, 0.f) - log1pf(__expf(-fabsf(x))); }
__device__ __forceinline__ float fgelu_tanh(float x) { const float u = 0.7978845608028654f * (x + 0.044715f * x * x * x); const float e = __expf(2.0f * u); const float t = 1.0f - 2.0f / (e + 1.0f); return 0.5f * x * (1.0f + t); }
__device__ __forceinline__ float wave_sum(float v) {
#pragma unroll
    for (int o = 1; o < 64; o <<= 1) v += __shfl_xor(v, o);
    return v;
}
__device__ __forceinline__ int opaque(int x) { asm volatile("" : "+v"(x)); return x; }
__device__ __forceinline__ unsigned char* opaque_ptr(unsigned char* p) { asm volatile("" : "+s"(p)); return p; }
#define LDS_WAIT() asm volatile("s_waitcnt lgkmcnt(0)" ::: "memory")
#define VM_WAIT() asm volatile("s_waitcnt vmcnt(0)" ::: "memory")
namespace pg8 {
constexpr int BM = 256, BK = 64, HALF = 128, HTB = HALF * BK * 2  , STAGE_BYTES = 8 * HTB, NXCD = 8, WGM = 8;
__host__ __device__ __forceinline__ int lds_byte(int r, int c) { const int st = (r >> 4) * 2 + (c >> 5), rr = r & 15, cc = c & 31, ob = rr * 64 + cc * 2; return st * 1024 + (ob ^ (((ob >> 9) & 1) << 5)); }
__host__ __device__ __forceinline__ void stage_rc(int b, int& R, int& C) { const int st = b / 1024, sb = b % 1024, swz = sb ^ (((sb >> 9) & 1) << 5); R = (st >> 1) * 16 + swz / 64; C = (st & 1) * 32 + (swz % 64) / 2; }
__host__ __device__ __forceinline__ int perm32(int rho) { const int n = rho >> 4, i = rho & 15; return 8 * (i >> 2) + 4 * n + (i & 3); }

struct Unit { int pm, pn, k0, ks, nt; };
struct Gemm { const bf16_t* A; const bf16_t* Bt; int M, N, K, lda, ldb; };

struct StaticOrder {
    int nM, nN, nwg, G, c, ntd;
    __host__ __device__ void init(int M, int N, int G_, int c_, int K_) { nM = M / BM; nN = N / BM; nwg = nM * nN; G = G_; c = c_; ntd = K_ / BK; }
    __host__ __device__ bool next(int i, Unit& u) const {
        const long L = (long)i * G + c; if (L >= nwg) return false;
        int wgid = (int)L; { const int q = nwg / NXCD, r = nwg % NXCD, xcd = wgid % NXCD, off = wgid / NXCD; wgid = (xcd < r ? xcd * (q + 1) : r * (q + 1) + (xcd - r) * q) + off; }
        const int nig = WGM * nN, gid = wgid / nig, fm = gid * WGM, gsz = (nM - fm) < WGM ? (nM - fm) : WGM;
        u.pm = fm + ((wgid % nig) % gsz); u.pn = (wgid % nig) / gsz; u.k0 = 0; u.ks = 0; u.nt = ntd; return true;
    }
    __device__ __forceinline__ void a_ready(const Unit&) const {}
    __device__ __forceinline__ void done(const Unit&) const {}
};
struct Order {
    int mode; StaticOrder so; int nN, ns, Ks, G, c;
    __host__ __device__ void init_all(int M, int N, int K, int G_, int c_) { mode = 0; so.init(M, N, G_, c_, K); }
    __host__ __device__ void init_latent(int N, int K, int G_, int c_) { mode = 1; so.init(8192, N, G_, c_, K); }
    __host__ __device__ void init_ctx(int N, int ns_, int Ks_, int G_, int c_) { mode = 2; nN = N / BM; ns = ns_; Ks = Ks_; G = G_; c = c_; }
    __host__ __device__ void init_merge(int G_, int c_) { mode = 3; so.init(8192, 2048, G_, c_, 1024); }
    __host__ __device__ bool next(int i, Unit& u) const {
        if (mode == 2) { const int L = i * G + c; if (L >= 4 * nN * ns) return false; u.pn = L % nN; u.pm = 9 * ((L / nN) & 3); u.ks = L / (4 * nN); u.k0 = u.ks * Ks; u.nt = Ks / BK; return true; }
        if (mode == 3) { const int seg = i % 3; if (!so.next(i / 3, u)) return false; u.pm = (u.pm >> 3) * 9 + 1 + (u.pm & 7); u.ks = seg; u.k0 = seg == 0 ? 0 : (seg == 1 ? 1024 : 1792); u.nt = seg == 1 ? 12 : 16; return true; }
        if (!so.next(i, u)) return false;
        if (mode == 1) u.pm = (u.pm >> 3) * 9 + 1 + (u.pm & 7);
        return true;
    }
    __device__ __forceinline__ void a_ready(const Unit&) const {}
    __device__ __forceinline__ void done(const Unit&) const {}
};
template <class Epi, class Sched, bool ALIGN_EPI = false, bool SP2 = false>
__device__ __forceinline__ void gemm_phase(LAS unsigned char* lds, const Gemm g, const Sched& S, const Epi& E) {
    const int tid = opaque(threadIdx.x), wid = __builtin_amdgcn_readfirstlane(tid >> 6), lane = tid & 63, wr = wid >> 2, wc = wid & 3, fr = lane & 15, fq = lane >> 4;
    unsigned voffA[2], voffB[2];
#pragma unroll
    for (int i = 0; i < 2; ++i) { int R, C; stage_rc(tid * 16 + i * 8192, R, C); const int Rb = Epi::PERM ? ((R & ~31) + perm32(R & 31)) : R;
        voffA[i] = (unsigned)(R * g.lda + C) * 2u; voffB[i] = (unsigned)(Rb * g.ldb + C) * 2u; }
    const size_t kstep = (size_t)(BK * 2);
    const size_t hstepA = (size_t)HALF * g.lda * 2, hstepB = (size_t)HALF * g.ldb * 2;
    const size_t tstepA = 2 * hstepA, tstepB = 2 * hstepB;
    const unsigned ldsw = (unsigned)wid * 1024u;
    const int aoff = lds_byte(wr * 64 + fr, fq * 8), boff = lds_byte(wc * 32 + fr, fq * 8);
#define PG8_SA(b, h) (((b) * 2 + (h)) * HTB)
#define PG8_SB(b, h) ((4 + (b) * 2 + (h)) * HTB)
#define PG8_STAGE(bufoff, gbase, voff) do { _Pragma("unroll") for (int _i = 0; _i < 2; ++_i) \
        __builtin_amdgcn_global_load_lds((const unsigned*)((const char*)(gbase) + (voff)[_i]), (LAS unsigned*)(lds + (bufoff) + ldsw + _i * 8192), 16, 0, 0); } while (0)
#define PG8_LDA(dst, b, h) do { _Pragma("unroll") for (int m = 0; m < 4; ++m) _Pragma("unroll") for (int k = 0; k < 2; ++k) dst[m][k] = *(const LAS bf16x8*)(lds + PG8_SA(b, h) + aoff + m * 2048 + k * 1024); } while (0)
#define PG8_LDB(dst, b, h) do { _Pragma("unroll") for (int n = 0; n < 2; ++n) _Pragma("unroll") for (int k = 0; k < 2; ++k) dst[n][k] = *(const LAS bf16x8*)(lds + PG8_SB(b, h) + boff + n * 2048 + k * 1024); } while (0)
#define PG8_MMA(ai, bj, At, Bt) do { __builtin_amdgcn_s_setprio(1); _Pragma("unroll") for (int m = 0; m < 4; ++m) _Pragma("unroll") for (int n = 0; n < 2; ++n) _Pragma("unroll") for (int k = 0; k < 2; ++k) \
        acc[ai][bj][m][n] = __builtin_amdgcn_mfma_f32_16x16x32_bf16(Bt[n][k], At[m][k], acc[ai][bj][m][n], 0, 0, 0); __builtin_amdgcn_s_setprio(0); } while (0)
#define PG8_WAIT_V(n) asm volatile("s_waitcnt vmcnt(" #n ")" ::: "memory")
#define PG8_WAIT_L(n) asm volatile("s_waitcnt lgkmcnt(" #n ")" ::: "memory")
#define PG8_BAR __builtin_amdgcn_s_barrier()
#define PG8_SCHED __builtin_amdgcn_sched_barrier(0)
    Unit cur, nxt; int ui = 0;
    if (!S.next(0, cur)) return;
    int nt = cur.nt;
    f32x4 acc[2][2][4][2];
#pragma unroll
    for (int a = 0; a < 2; ++a)
#pragma unroll
        for (int b = 0; b < 2; ++b)
#pragma unroll
            for (int m = 0; m < 4; ++m)
#pragma unroll
                for (int n = 0; n < 2; ++n) acc[a][b][m][n] = (f32x4){0.f, 0.f, 0.f, 0.f};
    bf16x8 At[4][2], B0[2][2], B1[2][2];
    const char* cA = (const char*)g.A + (size_t)cur.pm * tstepA + (size_t)cur.k0 * 2; const char* cB = (const char*)g.Bt + (size_t)cur.pn * tstepB + (size_t)cur.k0 * 2;
    S.a_ready(cur);
    if constexpr (SP2) {
        PG8_STAGE(PG8_SB(0, 0), cB, voffB); PG8_STAGE(PG8_SB(0, 1), cB + hstepB, voffB); PG8_STAGE(PG8_SA(0, 0), cA, voffA); PG8_STAGE(PG8_SA(0, 1), cA + hstepA, voffA);
        if (wr == 1) PG8_BAR;
        PG8_WAIT_V(2); PG8_BAR;
        PG8_STAGE(PG8_SB(1, 0), cB + kstep, voffB); PG8_STAGE(PG8_SA(1, 0), cA + kstep, voffA); PG8_STAGE(PG8_SB(1, 1), cB + hstepB + kstep, voffB);
        PG8_WAIT_V(6); PG8_BAR;
    } else {
        PG8_STAGE(PG8_SB(0, 0), cB, voffB); PG8_STAGE(PG8_SA(0, 0), cA, voffA); PG8_STAGE(PG8_SB(0, 1), cB + hstepB, voffB); PG8_STAGE(PG8_SA(0, 1), cA + hstepA, voffA);
        if (wr == 1) PG8_BAR;
        PG8_WAIT_V(4); PG8_BAR;
        PG8_STAGE(PG8_SB(1, 0), cB + kstep, voffB); PG8_STAGE(PG8_SA(1, 0), cA + kstep, voffA); PG8_STAGE(PG8_SB(1, 1), cB + hstepB + kstep, voffB);
        PG8_WAIT_V(6); PG8_BAR;
    }
    for (;;) {
        const bool has_next = S.next(ui + 1, nxt);
        const char* nA = has_next ? (const char*)g.A + (size_t)nxt.pm * tstepA + (size_t)nxt.k0 * 2 : cA; const char* nB = has_next ? (const char*)g.Bt + (size_t)nxt.pn * tstepB + (size_t)nxt.k0 * 2 : cB;
        for (int t = 0; t < nt; t += 2) {
            const bool last = (t == nt - 2);
            const char* a1 = cA + (size_t)(t + 1) * kstep;
            const char* a2 = last ? nA : cA + (size_t)(t + 2) * kstep; const char* b2 = last ? nB : cB + (size_t)(t + 2) * kstep;
            const char* a3 = a2 + kstep; const char* b3 = b2 + kstep;
            if (last && has_next) S.a_ready(nxt);
            if constexpr (SP2) {
            PG8_LDB(B0, 0, 0); PG8_LDB(B1, 0, 1); PG8_SCHED; PG8_LDA(At, 0, 0); PG8_STAGE(PG8_SA(1, 1), a1 + hstepA, voffA);
            PG8_WAIT_V(8); PG8_WAIT_L(0); PG8_BAR; PG8_MMA(0, 0, At, B0); PG8_MMA(0, 1, At, B1); PG8_BAR; PG8_SCHED;
            PG8_LDA(At, 0, 1); PG8_STAGE(PG8_SB(0, 0), b2, voffB); PG8_STAGE(PG8_SB(0, 1), b2 + hstepB, voffB); PG8_STAGE(PG8_SA(0, 0), a2, voffA);
            PG8_WAIT_V(8); PG8_WAIT_L(0); PG8_BAR; PG8_MMA(1, 0, At, B0); PG8_MMA(1, 1, At, B1); PG8_BAR; PG8_SCHED;
            PG8_LDB(B0, 1, 0); PG8_LDB(B1, 1, 1); PG8_SCHED; PG8_LDA(At, 1, 0); PG8_STAGE(PG8_SA(0, 1), a2 + hstepA, voffA);
            PG8_WAIT_V(8); PG8_WAIT_L(0); PG8_BAR; PG8_MMA(0, 0, At, B0); PG8_MMA(0, 1, At, B1); PG8_BAR; PG8_SCHED;
            PG8_LDA(At, 1, 1); PG8_STAGE(PG8_SB(1, 0), b3, voffB); PG8_STAGE(PG8_SB(1, 1), b3 + hstepB, voffB); PG8_STAGE(PG8_SA(1, 0), a3, voffA);
            PG8_WAIT_V(8); PG8_WAIT_L(0); PG8_BAR; PG8_MMA(1, 0, At, B0); PG8_MMA(1, 1, At, B1); PG8_BAR; PG8_SCHED;
            } else {
            PG8_LDB(B0, 0, 0); PG8_SCHED; PG8_LDA(At, 0, 0); PG8_STAGE(PG8_SA(1, 1), a1 + hstepA, voffA);
            PG8_WAIT_L(8); PG8_BAR; PG8_WAIT_L(0); PG8_MMA(0, 0, At, B0); PG8_BAR; PG8_SCHED;
            PG8_LDB(B1, 0, 1); PG8_STAGE(PG8_SB(0, 0), b2, voffB);
            PG8_BAR; PG8_WAIT_L(0); PG8_MMA(0, 1, At, B1); PG8_BAR;
            PG8_LDA(At, 0, 1); PG8_STAGE(PG8_SA(0, 0), a2, voffA);
            PG8_BAR; PG8_WAIT_L(0); PG8_MMA(1, 0, At, B0); PG8_BAR; PG8_SCHED;
            PG8_STAGE(PG8_SB(0, 1), b2 + hstepB, voffB);
            PG8_WAIT_V(6); PG8_BAR; PG8_MMA(1, 1, At, B1); PG8_BAR;
            PG8_LDB(B0, 1, 0); PG8_SCHED; PG8_LDA(At, 1, 0); PG8_STAGE(PG8_SA(0, 1), a2 + hstepA, voffA);
            PG8_WAIT_L(8); PG8_BAR; PG8_WAIT_L(0); PG8_MMA(0, 0, At, B0); PG8_BAR; PG8_SCHED;
            PG8_LDB(B1, 1, 1); PG8_STAGE(PG8_SB(1, 0), b3, voffB);
            PG8_BAR; PG8_WAIT_L(0); PG8_MMA(0, 1, At, B1); PG8_BAR;
            PG8_LDA(At, 1, 1); PG8_STAGE(PG8_SA(1, 0), a3, voffA);
            PG8_BAR; PG8_WAIT_L(0); PG8_MMA(1, 0, At, B0); PG8_BAR; PG8_SCHED;
            PG8_STAGE(PG8_SB(1, 1), b3 + hstepB, voffB);
            PG8_WAIT_V(6); PG8_BAR; PG8_MMA(1, 1, At, B1); PG8_BAR;
            }
        }
        if constexpr (ALIGN_EPI) { if (wr == 0) PG8_BAR; }
        E(acc, cur, wr, wc, fr, fq); S.done(cur);
        if (!has_next) break;
#pragma unroll
        for (int a = 0; a < 2; ++a)
#pragma unroll
            for (int b = 0; b < 2; ++b)
#pragma unroll
                for (int m = 0; m < 4; ++m)
#pragma unroll
                    for (int n = 0; n < 2; ++n) acc[a][b][m][n] = (f32x4){0.f, 0.f, 0.f, 0.f};
        cur = nxt; cA = nA; cB = nB; ++ui; nt = cur.nt;
        if constexpr (ALIGN_EPI) { if (wr == 1) PG8_BAR; }
    }
    PG8_WAIT_V(0);
    if constexpr (!ALIGN_EPI) { if (wr == 0) PG8_BAR; }
    PG8_BAR;
#undef PG8_SA
#undef PG8_SB
#undef PG8_STAGE
#undef PG8_LDA
#undef PG8_LDB
#undef PG8_MMA
#undef PG8_WAIT_V
#undef PG8_WAIT_L
#undef PG8_BAR
#undef PG8_SCHED
}
}
namespace pg8 {
struct EpiInProj {
    static constexpr bool PERM = true;
    bf16_t* Y; float* GLR;
    __device__ __forceinline__ void operator()(const f32x4 (&acc)[2][2][4][2], const Unit& u, int wr, int wc, int fr, int fq) const {
        const int colt = u.pn * BM, row0 = u.pm * BM + wr * 64 + fr;
        if (colt >= YW) {
            if (wc == 0 && fq < 2) {
#pragma unroll
                for (int ai = 0; ai < 2; ++ai)
#pragma unroll
                    for (int m = 0; m < 4; ++m) { float* p = GLR + (size_t)(row0 + ai * HALF + m * 16) * 16 + 8 * fq;
                        *(f32x4*)p = acc[ai][0][m][0]; *(f32x4*)(p + 4) = acc[ai][0][m][1]; }
            }
            return;
        }
        const int mode = (colt < Y_GK) ? 1 : ((colt >= Y_GR && colt < Y_SU) ? 2 : (colt >= Y_BG ? 3 : 0));
        const int col0 = colt + wc * 32 + 8 * fq;
#pragma unroll
        for (int ai = 0; ai < 2; ++ai)
#pragma unroll
            for (int m = 0; m < 4; ++m) { bf16_t* rowp = Y + (size_t)(row0 + ai * HALF + m * 16) * YW + col0;
#pragma unroll
                for (int bj = 0; bj < 2; ++bj) { f32x4 v0 = acc[ai][bj][m][0], v1 = acc[ai][bj][m][1];
                    if (mode == 1) { v0 *= 0.08838834764831845f; v1 *= 0.08838834764831845f; }
                    else if (mode == 2) {
#pragma unroll
                        for (int j = 0; j < 4; ++j) { v0[j] = fsilu(v0[j]); v1[j] = fsilu(v1[j]); } }
                    else if (mode == 3) {
#pragma unroll
                        for (int j = 0; j < 4; ++j) { v0[j] = fsigmoid(v0[j]); v1[j] = fsigmoid(v1[j]); } }
                    u32x4 w; w.x = cvt_pk_bf16(v0[0], v0[1]); w.y = cvt_pk_bf16(v0[2], v0[3]); w.z = cvt_pk_bf16(v1[0], v1[1]); w.w = cvt_pk_bf16(v1[2], v1[3]);
                    *(u32x4*)(rowp + bj * HALF) = w; } }
    }
};
struct EpiGlu {
    static constexpr bool PERM = true;
    const bf16_t* YG; bf16_t* OC;
    __device__ __forceinline__ void operator()(const f32x4 (&acc)[2][2][4][2], const Unit& u, int wr, int wc, int fr, int fq) const {
        const int row0 = u.pm * BM + wr * 64 + fr, col0 = u.pn * BM + wc * 32 + 8 * fq;
#pragma unroll
        for (int ai = 0; ai < 2; ++ai)
#pragma unroll
            for (int m = 0; m < 4; ++m) { const size_t row = (size_t)(row0 + ai * HALF + m * 16);
#pragma unroll
                for (int bj = 0; bj < 2; ++bj) { const f32x4 v0 = acc[ai][bj][m][0], v1 = acc[ai][bj][m][1];
                    const u32x4 y = *(const u32x4*)(YG + row * 768 + col0 + bj * HALF);
                    u32x4 w;
                    w.x = cvt_pk_bf16(lo_bf(y.x) * fsigmoid(v0[0]), hi_bf(y.x) * fsigmoid(v0[1])); w.y = cvt_pk_bf16(lo_bf(y.y) * fsigmoid(v0[2]), hi_bf(y.y) * fsigmoid(v0[3]));
                    w.z = cvt_pk_bf16(lo_bf(y.z) * fsigmoid(v1[0]), hi_bf(y.z) * fsigmoid(v1[1])); w.w = cvt_pk_bf16(lo_bf(y.w) * fsigmoid(v1[2]), hi_bf(y.w) * fsigmoid(v1[3]));
                    *(u32x4*)(OC + row * OCW + 1024 + col0 + bj * HALF) = w; } }
    }
};
template <int STAGE> struct EpiMerge {
    static constexpr bool PERM = true;
    const bf16_t* Y; float* T; bf16_t* O;
    __device__ __forceinline__ void operator()(const f32x4 (&acc)[2][2][4][2], const Unit& u, int wr, int wc, int fr, int fq) const {
        const int row0 = u.pm * BM + wr * 64 + fr, col0 = u.pn * BM + wc * 32 + 8 * fq;
#pragma unroll
        for (int ai = 0; ai < 2; ++ai)
#pragma unroll
            for (int m = 0; m < 4; ++m) { const size_t row = (size_t)(row0 + ai * HALF + m * 16);
#pragma unroll
                for (int bj = 0; bj < 2; ++bj) { const int c = col0 + bj * HALF;
                    const u32x4 gt = *(const u32x4*)(Y + row * YW + Y_BG + STAGE * 2048 + c);
                    f32x4 v0 = acc[ai][bj][m][0], v1 = acc[ai][bj][m][1];
                    v0[0] *= lo_bf(gt.x); v0[1] *= hi_bf(gt.x); v0[2] *= lo_bf(gt.y); v0[3] *= hi_bf(gt.y);
                    v1[0] *= lo_bf(gt.z); v1[1] *= hi_bf(gt.z); v1[2] *= lo_bf(gt.w); v1[3] *= hi_bf(gt.w);
                    float* tp = T + row * DM + c;
                    if (STAGE > 0) { v0 += *(const f32x4*)tp; v1 += *(const f32x4*)(tp + 4); }
                    if (STAGE < 2) { *(f32x4*)tp = v0; *(f32x4*)(tp + 4) = v1; }
                    else { u32x4 w; w.x = cvt_pk_bf16(v0[0], v0[1]); w.y = cvt_pk_bf16(v0[2], v0[3]); w.z = cvt_pk_bf16(v1[0], v1[1]); w.w = cvt_pk_bf16(v1[2], v1[3]);
                        *(u32x4*)(O + row * DM + c) = w; } } }
    }
};
struct EpiMergeRT {
    static constexpr bool PERM = true;
    const bf16_t* Y; float* T; bf16_t* O;
    __device__ __forceinline__ void operator()(const f32x4 (&acc)[2][2][4][2], const Unit& u, int wr, int wc, int fr, int fq) const {
        const int row0 = u.pm * BM + wr * 64 + fr, col0 = u.pn * BM + wc * 32 + 8 * fq, stage = u.ks;
#pragma unroll
        for (int ai = 0; ai < 2; ++ai)
#pragma unroll
            for (int m = 0; m < 4; ++m) { const size_t row = (size_t)(row0 + ai * HALF + m * 16);
#pragma unroll
                for (int bj = 0; bj < 2; ++bj) { const int c = col0 + bj * HALF;
                    const u32x4 gt = *(const u32x4*)(Y + row * YW + Y_BG + stage * 2048 + c);
                    f32x4 v0 = acc[ai][bj][m][0], v1 = acc[ai][bj][m][1];
                    v0[0] *= lo_bf(gt.x); v0[1] *= hi_bf(gt.x); v0[2] *= lo_bf(gt.y); v0[3] *= hi_bf(gt.y);
                    v1[0] *= lo_bf(gt.z); v1[1] *= hi_bf(gt.z); v1[2] *= lo_bf(gt.w); v1[3] *= hi_bf(gt.w);
                    float* tp = T + row * DM + c;
                    if (stage > 0) { v0 += *(const f32x4*)tp; v1 += *(const f32x4*)(tp + 4); }
                    if (stage < 2) { *(f32x4*)tp = v0; *(f32x4*)(tp + 4) = v1; }
                    else { u32x4 w; w.x = cvt_pk_bf16(v0[0], v0[1]); w.y = cvt_pk_bf16(v0[2], v0[3]); w.z = cvt_pk_bf16(v1[0], v1[1]); w.w = cvt_pk_bf16(v1[2], v1[3]);
                        *(u32x4*)(O + row * DM + c) = w; } } }
    }
};
struct EpiResid {
    static constexpr bool PERM = true;
    const float* X; float* Z; const float* gate;
    __device__ __forceinline__ void operator()(const f32x4 (&acc)[2][2][4][2], const Unit& u, int wr, int wc, int fr, int fq) const {
        const int row0 = u.pm * BM + wr * 64 + fr, col0 = u.pn * BM + wc * 32 + 8 * fq;
        const int cond = (u.pm % 9 == 0) ? 4 : (u.pm / 9);
        const float* gp = gate + (size_t)cond * NMOD + col0;
        f32x4 g[2][2];
#pragma unroll
        for (int bj = 0; bj < 2; ++bj) { g[bj][0] = *(const f32x4*)(gp + bj * HALF); g[bj][1] = *(const f32x4*)(gp + bj * HALF + 4); }
#pragma unroll
        for (int ai = 0; ai < 2; ++ai)
#pragma unroll
            for (int m = 0; m < 4; ++m) { const size_t off = (size_t)(row0 + ai * HALF + m * 16) * DM + col0;
#pragma unroll
                for (int bj = 0; bj < 2; ++bj) {
                    const f32x4 x0 = *(const f32x4*)(X + off + bj * HALF), x1 = *(const f32x4*)(X + off + bj * HALF + 4);
                    *(f32x4*)(Z + off + bj * HALF) = x0 * DN_ALPHA + g[bj][0] * acc[ai][bj][m][0];
                    *(f32x4*)(Z + off + bj * HALF + 4) = x1 * DN_ALPHA + g[bj][1] * acc[ai][bj][m][1]; } }
    }
};
struct EpiSwiglu {
    static constexpr bool PERM = true;
    bf16_t* ACT;
    __device__ __forceinline__ void operator()(const f32x4 (&acc)[2][2][4][2], const Unit& u, int wr, int wc, int fr, int fq) const {
        const int row0 = u.pm * BM + wr * 64 + fr, col0 = u.pn * HALF + wc * 32 + 8 * fq;
#pragma unroll
        for (int ai = 0; ai < 2; ++ai)
#pragma unroll
            for (int m = 0; m < 4; ++m) { const f32x4 a0 = acc[ai][0][m][0], a1 = acc[ai][0][m][1], b0 = acc[ai][1][m][0], b1 = acc[ai][1][m][1];
                u32x4 w; w.x = cvt_pk_bf16(fsilu(a0[0]) * b0[0], fsilu(a0[1]) * b0[1]); w.y = cvt_pk_bf16(fsilu(a0[2]) * b0[2], fsilu(a0[3]) * b0[3]);
                w.z = cvt_pk_bf16(fsilu(a1[0]) * b1[0], fsilu(a1[1]) * b1[1]); w.w = cvt_pk_bf16(fsilu(a1[2]) * b1[2], fsilu(a1[3]) * b1[3]);
                *(u32x4*)(ACT + (size_t)(row0 + ai * HALF + m * 16) * DFF + col0) = w; }
    }
};
struct EpiPartial {
    static constexpr bool PERM = true;
    float* P;
    __device__ __forceinline__ void operator()(const f32x4 (&acc)[2][2][4][2], const Unit& u, int wr, int wc, int fr, int fq) const {
        const int row0 = (u.pm / 9) * BM + wr * 64 + fr, col0 = u.pn * BM + wc * 32 + 8 * fq;
        float* base = P + (size_t)u.ks * 1024 * DM;
#pragma unroll
        for (int ai = 0; ai < 2; ++ai)
#pragma unroll
            for (int m = 0; m < 4; ++m) { float* rp = base + (size_t)(row0 + ai * HALF + m * 16) * DM + col0;
#pragma unroll
                for (int bj = 0; bj < 2; ++bj) { *(f32x4*)(rp + bj * HALF) = acc[ai][bj][m][0]; *(f32x4*)(rp + bj * HALF + 4) = acc[ai][bj][m][1]; } }
    }
};
}
namespace att {
constexpr int D = 128, NW = 8, QBLK = 32, KVBLK = 64;
constexpr float SCALE = 0.088388347648318440f;
constexpr float THR = 8.f;
#ifndef ATT_SDEPTH
#define ATT_SDEPTH 1
#endif
constexpr int SDEPTH = ATT_SDEPTH;
constexpr int LDQ = 1024, LDK = 256, LDV = YW, LDO = OCW;
constexpr size_t SHM_V = KVBLK * D * 2, SHM_K = KVBLK * D * 2, SHM_ATTN = 2 * SHM_V + 2 * SHM_K + NW * 64 * 4;
#define KSWZ(row, colB) ((row) * 256 + ((colB) ^ (((row) & 7) << 4)))
#define SBAR() __builtin_amdgcn_sched_barrier(0)
__device__ __forceinline__ int crow(int r, int hi) { return (r & 3) + 8 * (r >> 2) + 4 * hi; }
__device__ __forceinline__ bf16x8 ld8(const bf16_t* p) { return *reinterpret_cast<const bf16x8*>(p); }

__device__ __forceinline__ void partialSM(f32x16& p0, f32x16& p1, float& m_reg, float& mn, float& alpha) {
  constexpr float C = SCALE * 1.4426950408889634f;
  float pmax = p0[0]; for (int r = 1; r < 16; ++r) pmax = fmaxf(pmax, p0[r]); for (int r = 0; r < 16; ++r) pmax = fmaxf(pmax, p1[r]);
  { auto rr = __builtin_amdgcn_permlane32_swap(__float_as_uint(pmax), __float_as_uint(pmax), false, false);
    pmax = fmaxf(__uint_as_float(rr[0]), __uint_as_float(rr[1])); }
  if (__builtin_expect(__all(pmax - m_reg <= THR / SCALE), 1)) { mn = m_reg; alpha = 1.f; }
  else { mn = fmaxf(m_reg, pmax); alpha = __builtin_amdgcn_exp2f((m_reg - mn) * C); m_reg = mn; }
  float mnC = -mn * C;
  for (int r = 0; r < 16; ++r) p0[r] = fmaf(p0[r], C, mnC); for (int r = 0; r < 16; ++r) p1[r] = fmaf(p1[r], C, mnC);
  for (int r = 0; r < 16; ++r) p0[r] = __builtin_amdgcn_exp2f(p0[r]);
}
__device__ __forceinline__ void finishSM(f32x16& p0, f32x16& p1, float alpha, float& l_reg, bf16x8& pa0, bf16x8& pa1, bf16x8& pa2, bf16x8& pa3) {
  for (int r = 0; r < 16; ++r) p1[r] = __builtin_amdgcn_exp2f(p1[r]);
  float ps = 0; for (int r = 0; r < 16; ++r) ps += p0[r]; for (int r = 0; r < 16; ++r) ps += p1[r];
  { auto rr = __builtin_amdgcn_permlane32_swap(__float_as_uint(ps), __float_as_uint(ps), false, false);
    ps = __uint_as_float(rr[0]) + __uint_as_float(rr[1]); }
  l_reg = l_reg * alpha + ps;
#define PK4(P, BASE, OUT) do { unsigned a0 = cvt_pk_bf16(P[BASE + 0], P[BASE + 1]), a1 = cvt_pk_bf16(P[BASE + 2], P[BASE + 3]);   \
    unsigned b0 = cvt_pk_bf16(P[BASE + 4], P[BASE + 5]), b1 = cvt_pk_bf16(P[BASE + 6], P[BASE + 7]);                              \
    auto r0 = __builtin_amdgcn_permlane32_swap(a0, b0, false, false); auto r1 = __builtin_amdgcn_permlane32_swap(a1, b1, false, false); \
    u32x4 w = {r0[0], r1[0], r0[1], r1[1]}; OUT = *reinterpret_cast<bf16x8*>(&w); } while (0)
  PK4(p0, 0, pa0); PK4(p0, 8, pa1); PK4(p1, 0, pa2); PK4(p1, 8, pa3);
#undef PK4
}
__device__ __forceinline__ void qkt(f32x16& p0, f32x16& p1, const bf16_t* Ks, const bf16x8* qr, int r32, int hi) {
  p0 = f32x16{}; p1 = f32x16{};
  for (int d0 = 0; d0 < 8; ++d0) { int cb = (d0 * 16 + hi * 8) * 2;
    bf16x8 b0 = *reinterpret_cast<const bf16x8*>((const char*)Ks + KSWZ(r32, cb));
    bf16x8 b1 = *reinterpret_cast<const bf16x8*>((const char*)Ks + KSWZ(32 + r32, cb));
    p0 = __builtin_amdgcn_mfma_f32_32x32x16_bf16(b0, qr[d0], p0, 0, 0, 0);
    p1 = __builtin_amdgcn_mfma_f32_32x32x16_bf16(b1, qr[d0], p1, 0, 0, 0); }
}
__device__ __forceinline__ int v_st(int k, int c) { const int kk = (k & ~0xC) | ((k & 4) << 1) | ((k & 8) >> 1); return ((kk >> 3) * 4 + (c >> 5)) * 512 + ((kk & 7) * 32 + (c & 31)) * 2; }
__device__ __forceinline__ int v_rd_base(int lane) { return ((lane & 3) << 3) | (((lane >> 2) & 3) << 6) | (((lane >> 4) & 1) << 5) | (((lane >> 5) & 1) << 8); }
constexpr int v_rd_off(int d0, int ks, int half) { return d0 * 512 + ks * 4096 + half * 2048; }
template <int OFF> __device__ __forceinline__ s16x4 tr_read(int vb) {
  s16x4 r; asm volatile("ds_read_b64_tr_b16 %0, %1 offset:%2" : "=&v"(r) : "v"(vb), "i"(OFF) : "memory"); return r;
}
template <int D0> __device__ __forceinline__ void pv_one(f32x16& od, int vb, bf16x8 pa0, bf16x8 pa1, bf16x8 pa2, bf16x8 pa3) {
  const s16x4 l0 = tr_read<v_rd_off(D0, 0, 0)>(vb), h0 = tr_read<v_rd_off(D0, 0, 1)>(vb), l1 = tr_read<v_rd_off(D0, 1, 0)>(vb), h1 = tr_read<v_rd_off(D0, 1, 1)>(vb);
  const s16x4 l2 = tr_read<v_rd_off(D0, 2, 0)>(vb), h2 = tr_read<v_rd_off(D0, 2, 1)>(vb), l3 = tr_read<v_rd_off(D0, 3, 0)>(vb), h3 = tr_read<v_rd_off(D0, 3, 1)>(vb);
  asm volatile("s_waitcnt lgkmcnt(0)" ::: "memory"); SBAR();
#define PK(L, H) (bf16x8){L[0], L[1], L[2], L[3], H[0], H[1], H[2], H[3]}
  od = __builtin_amdgcn_mfma_f32_32x32x16_bf16(pa0, PK(l0, h0), od, 0, 0, 0);
  od = __builtin_amdgcn_mfma_f32_32x32x16_bf16(pa1, PK(l1, h1), od, 0, 0, 0);
  od = __builtin_amdgcn_mfma_f32_32x32x16_bf16(pa2, PK(l2, h2), od, 0, 0, 0);
  od = __builtin_amdgcn_mfma_f32_32x32x16_bf16(pa3, PK(l3, h3), od, 0, 0, 0);
#undef PK
}
__device__ __forceinline__ void pv_d0(f32x16* o, int vb, bf16x8 pa0, bf16x8 pa1, bf16x8 pa2, bf16x8 pa3) {
  pv_one<0>(o[0], vb, pa0, pa1, pa2, pa3); pv_one<1>(o[1], vb, pa0, pa1, pa2, pa3); pv_one<2>(o[2], vb, pa0, pa1, pa2, pa3); pv_one<3>(o[3], vb, pa0, pa1, pa2, pa3);
}
__device__ __forceinline__ void attn_dense_body(const bf16_t* __restrict__ Qb, const bf16_t* __restrict__ Kh, const bf16_t* __restrict__ Vh,
                                                bf16_t* __restrict__ Ob, int seq, char* lds) {
  const int tid = opaque(threadIdx.x), wid = tid >> 6, lane = tid & 63, r32 = lane & 31, hi = lane >> 5;
  bf16_t* V_lds = (bf16_t*)lds; bf16_t* K_lds = (bf16_t*)(lds + 2 * SHM_V);
  float* ws = (float*)(lds + 2 * SHM_V + 2 * SHM_K) + wid * 64; float* li_l = ws; float* al_l = ws + 32;
  float m_reg = -1e30f, l_reg = 0; f32x16 o[4] = {}; bf16x8 qr[8];
  const bf16_t* Qw = Qb + (unsigned)((wid * QBLK + r32) * LDQ + hi * 8);
#pragma unroll
  for (int d0 = 0; d0 < 8; ++d0) qr[d0] = ld8(Qw + d0 * 16);
  const int sr = tid >> 4, sc = (tid & 15) * 8, vst0 = v_st(sr, sc), vst1 = v_st(32 + sr, sc);
  const int vb0 = (int)(uintptr_t)V_lds + v_rd_base(lane);
  struct { bf16x8 vs0, vs1, ks0, ks1; } sr_[SDEPTH];
  const unsigned voff0 = (unsigned)(sr * LDV + sc), voff1 = (unsigned)((32 + sr) * LDV + sc), koff0 = (unsigned)(sr * LDK + sc), koff1 = (unsigned)((32 + sr) * LDK + sc);
#define SLOAD(i, k0) do { const bf16_t* vb_ = Vh + (size_t)(k0) * LDV; const bf16_t* kb_ = Kh + (size_t)(k0) * LDK; \
    sr_[i].vs0 = ld8(vb_ + voff0); sr_[i].vs1 = ld8(vb_ + voff1); sr_[i].ks0 = ld8(kb_ + koff0); sr_[i].ks1 = ld8(kb_ + koff1); } while (0)
#define SWRITE(b, i) do { *(bf16x8*)((char*)V_lds + (b) * SHM_V + vst0) = sr_[i].vs0;          \
    *(bf16x8*)((char*)V_lds + (b) * SHM_V + vst1) = sr_[i].vs1; int kc = sc * 2;               \
    *(bf16x8*)((char*)K_lds + (b) * SHM_K + KSWZ(sr, kc)) = sr_[i].ks0;                       \
    *(bf16x8*)((char*)K_lds + (b) * SHM_K + KSWZ(32 + sr, kc)) = sr_[i].ks1; } while (0)
#define SWAIT() do { if constexpr (SDEPTH == 2) asm volatile("s_waitcnt vmcnt(4)" ::: "memory"); else asm volatile("s_waitcnt vmcnt(0)" ::: "memory"); } while (0)
#define RESC(a) do { if (__any((a) < 1.f)) { if (hi == 0) al_l[r32] = (a); asm volatile("s_waitcnt lgkmcnt(0)" ::: "memory"); \
    for (int d = 0; d < 4; ++d) for (int r = 0; r < 16; ++r) o[d][r] *= al_l[crow(r, hi)]; } } while (0)
  f32x16 pA0, pA1, pB0, pB1; float mnA, mnB, alA, alB; bf16x8 pa0, pa1, pa2, pa3; const int NT = seq / KVBLK;
  constexpr int SE = 0, SO = SDEPTH - 1;
  SLOAD(SE, 0); asm volatile("s_waitcnt vmcnt(0)" ::: "memory"); SWRITE(0, SE); __syncthreads();
  qkt(pA0, pA1, K_lds, qr, r32, hi); partialSM(pA0, pA1, m_reg, mnA, alA);
  SLOAD(SO, KVBLK); if constexpr (SDEPTH == 2) { if (2 < NT) SLOAD(SE, 2 * KVBLK); }
  SWAIT(); SWRITE(1, SO); __syncthreads();
  for (int j = 1; j + 1 < NT; j += 2) {
    SBAR(); qkt(pB0, pB1, (bf16_t*)((char*)K_lds + SHM_K), qr, r32, hi);
    finishSM(pA0, pA1, alA, l_reg, pa0, pa1, pa2, pa3); SBAR();
    SLOAD(SO, (j + SDEPTH) * KVBLK); SBAR();
    pv_d0(o, vb0, pa0, pa1, pa2, pa3); partialSM(pB0, pB1, m_reg, mnB, alB);
    __syncthreads(); SWAIT(); SWRITE(0, SE);
    RESC(alB); __syncthreads();
    SBAR(); qkt(pA0, pA1, K_lds, qr, r32, hi);
    finishSM(pB0, pB1, alB, l_reg, pa0, pa1, pa2, pa3); SBAR();
    if (SDEPTH == 1 || j + 3 < NT) SLOAD(SE, (j + 1 + SDEPTH) * KVBLK); SBAR();
    pv_d0(o, vb0 + (int)SHM_V, pa0, pa1, pa2, pa3); partialSM(pA0, pA1, m_reg, mnA, alA);
    __syncthreads(); SWAIT(); SWRITE(1, SO);
    RESC(alA); __syncthreads();
  }
  SBAR(); qkt(pB0, pB1, (bf16_t*)((char*)K_lds + SHM_K), qr, r32, hi);
  finishSM(pA0, pA1, alA, l_reg, pa0, pa1, pa2, pa3); SBAR();
  pv_d0(o, vb0, pa0, pa1, pa2, pa3); partialSM(pB0, pB1, m_reg, mnB, alB);
  __syncthreads(); RESC(alB);
  finishSM(pB0, pB1, alB, l_reg, pa0, pa1, pa2, pa3); SBAR();
  pv_d0(o, vb0 + (int)SHM_V, pa0, pa1, pa2, pa3);
  if (hi == 0) li_l[r32] = l_reg; asm volatile("s_waitcnt lgkmcnt(0)" ::: "memory");
  float rli[16];
#pragma unroll
  for (int r = 0; r < 16; ++r) rli[r] = __builtin_amdgcn_rcpf(li_l[crow(r, hi)]);
  const unsigned ooff = (unsigned)((wid * QBLK + 4 * hi) * LDO + r32);
#pragma unroll
  for (int r = 0; r < 16; ++r) { const int orow = (r & 3) + 8 * (r >> 2);
#pragma unroll
    for (int d0 = 0; d0 < 4; ++d0) Ob[ooff + (unsigned)(orow * LDO + d0 * 32)] = f2bf(o[d0][r] * rli[r]); }
#undef SLOAD
#undef SWRITE
#undef SWAIT
#undef RESC
}
#undef KSWZ
}
#define XB_TMO      128
#define XB_XCNT(j)  (256  + 64 * (j))
#define XB_XSUB(j)  (1280 + 64 * (j))
#define XB_XGEN(j)  (2304 + 64 * (j))
#define XB_TOP      3328
#define XB_TOPGEN   3392
#define XCD_BAR_WORDS 3456
#define XB_SPIN_CAP (1u << 18)

__device__ __forceinline__ unsigned xb_ld(unsigned* p)              { return __hip_atomic_load(p, __ATOMIC_RELAXED, __HIP_MEMORY_SCOPE_AGENT); }
__device__ __forceinline__ unsigned xb_add(unsigned* p, unsigned v) { return __hip_atomic_fetch_add(p, v, __ATOMIC_RELAXED, __HIP_MEMORY_SCOPE_AGENT); }
__device__ __forceinline__ unsigned xb_xcc_id() { return (unsigned)__builtin_amdgcn_s_getreg((3 << 11) | 20) & 0xFu; }
#define XB_SPIN(cond, bar) do { unsigned _sp = 0; while (cond) { __builtin_amdgcn_s_sleep(1); \
    if ((++_sp & 255u) == 0u) { if (xb_ld(&(bar)[XB_TMO])) break; if (_sp > XB_SPIN_CAP) { atomicAdd(&(bar)[XB_TMO], 1u); break; } } } } while (0)

struct XcdBarrier {
    unsigned* bar; unsigned x;
    volatile LAS unsigned* st;
};
__device__ __forceinline__ XcdBarrier xcd_barrier_post(unsigned* bar, volatile LAS unsigned* st) {
    XcdBarrier b; b.bar = bar; b.x = xb_xcc_id(); b.st = st;
    if (threadIdx.x == 0) (void)xb_add(&bar[XB_XCNT(b.x)], 1u);
    return b;
}
__device__ __forceinline__ void xcd_barrier_complete(unsigned* bar, unsigned x, unsigned& nloc, unsigned& nx) {
    const unsigned G = gridDim.x * gridDim.y * gridDim.z;
    unsigned sum, cnt, mine, sp = 0u;
    for (;;) {
        sum = 0u; cnt = 0u; mine = 0u;
#pragma unroll
        for (unsigned j = 0; j < 16; ++j) { const unsigned c = xb_ld(&bar[XB_XCNT(j)]); sum += c; cnt += (c > 0u) ? 1u : 0u; mine = (j == x) ? c : mine; }
        if (sum == G) break;
        __builtin_amdgcn_s_sleep(1);
        if ((++sp & 255u) == 0u) { if (xb_ld(&bar[XB_TMO])) break; if (sp > XB_SPIN_CAP) { atomicAdd(&bar[XB_TMO], 1u); break; } }
    }
    nloc = mine > 0u ? mine : 1u; nx = cnt > 0u ? cnt : 1u;
}
__device__ __forceinline__ void xcd_barrier(const XcdBarrier& b) {
    asm volatile("s_waitcnt vmcnt(0)" ::: "memory");
    __syncthreads();
    if (threadIdx.x == 0) {
        unsigned* bar = b.bar;
        __builtin_amdgcn_s_waitcnt(0);
        unsigned nloc = b.st[0], nx = b.st[1];
        if (nloc == 0u) { xcd_barrier_complete(bar, b.x, nloc, nx); b.st[0] = nloc; b.st[1] = nx; }
        const unsigned old = xb_add(&bar[XB_XSUB(b.x)], 1u);
        const unsigned gen = old / nloc;
        if (old + 1u == (gen + 1u) * nloc) {
            __builtin_amdgcn_fence(__ATOMIC_RELEASE, "agent");
            asm volatile("s_waitcnt vmcnt(0)" ::: "memory");
            const unsigned og = xb_add(&bar[XB_TOP], 1u);
            const unsigned tg = og / nx;
            if (og + 1u == (tg + 1u) * nx) xb_add(&bar[XB_TOPGEN], 1u);
            else XB_SPIN(xb_ld(&bar[XB_TOPGEN]) == tg, bar);
            __builtin_amdgcn_fence(__ATOMIC_ACQUIRE, "agent");
            xb_add(&bar[XB_XGEN(b.x)], 1u);
            asm volatile("s_waitcnt vmcnt(0)" ::: "memory");
        } else {
            XB_SPIN(xb_ld(&bar[XB_XGEN(b.x)]) == gen, bar);
            __builtin_amdgcn_fence(__ATOMIC_ACQUIRE, "agent");
            asm volatile("s_waitcnt vmcnt(0)" ::: "memory");
        }
    }
    __syncthreads();
}
constexpr int NWAVES = 8;
constexpr int RING_BYTES = 131072, LDSCTL_OFF = 135168, MISC_OFF = LDSCTL_OFF + 320, LDS_BYTES = 147456;
constexpr int CW_BAR = 4096, CW_QUEUE = 8192;
constexpr int NPH_PRO = 3, NPH_LAYER = 11, NPH_TOTAL = NPH_PRO + DEPTH * NPH_LAYER;
struct Args { const float* in[31]; float* out; unsigned char* ws; int ph_lo, ph_hi; };
enum { I_X = 0, I_C, I_CTX, I_CCTX, I_WADA, I_BADA, I_WIN, I_WGATE, I_BGATE, I_GLANW, I_LAMRE, I_LAMIM, I_LOGDT, I_BRE, I_BIM, I_CRE, I_CIM, I_S5D, I_WGLU, I_QNW, I_KNW,
       I_WPG, I_WPS, I_WPA, I_WOUT, I_LN1W, I_LN1B, I_LN2W, I_LN2B, I_WFFI, I_WFFO };

template <int MAP> __device__ __forceinline__ int map_col(int n) {
    if (MAP == 1) return n < 3072 ? n : (n < 11520 ? n + 16 : (n < 11536 ? n - 8448 : -1));
    if (MAP == 2) { const int j = n >> 8, r = n & 255; return r < 128 ? 128 * j + r : DFF + 128 * j + (r - 128); }
    return n;
}
template <int MAP> __device__ __forceinline__ void transpose_item(const float* src, int sld, bf16_t* dst, int dld, int kb, int nb, LAS float* scr, int lane) {
    const int k0 = 64 * kb, n0 = 64 * nb, sc = map_col<MAP>(n0 + lane);
    const float* sp = src + (size_t)k0 * sld + (sc >= 0 ? sc : 0);
#pragma unroll 8
    for (int i = 0; i < 64; ++i) { const float v = sp[(size_t)i * sld]; scr[i * 65 + lane] = (sc >= 0) ? v : 0.f; }
    LDS_WAIT();
    const int c = lane & 7, ns = lane >> 3;
#pragma unroll
    for (int jn = 0; jn < 8; ++jn) { const int nn = jn * 8 + ns; const LAS float* s = scr + (8 * c) * 65 + nn;
        u32x4 o; o.x = cvt_pk_bf16(s[0 * 65], s[1 * 65]); o.y = cvt_pk_bf16(s[2 * 65], s[3 * 65]); o.z = cvt_pk_bf16(s[4 * 65], s[5 * 65]); o.w = cvt_pk_bf16(s[6 * 65], s[7 * 65]);
        *(u32x4*)(dst + (size_t)(n0 + nn) * dld + k0 + 8 * c) = o; }
    LDS_WAIT();
}
__device__ __forceinline__ void p0_prologue(const Args& a, LAS unsigned char* lds) {
    const int tid = threadIdx.x, lane = tid & 63, wave = __builtin_amdgcn_readfirstlane(tid >> 6);
    const int gw = blockIdx.x * NWAVES + wave, NGW = gridDim.x * NWAVES;
    LAS float* scr = (LAS float*)(lds + wave * 16640);
    constexpr int I_IN = 32 * 184, I_GLU = 12 * 12, I_CG = 16 * 32, I_CS = 12 * 32, I_CA = 16 * 32, I_OUT = 32 * 32, I_FFI = 32 * 176, I_FFO = 88 * 32;
    constexpr int PER_L = I_IN + I_GLU + I_CG + I_CS + I_CA + I_OUT + I_FFI + I_FFO;
    for (int it = gw; it < DEPTH * PER_L; it += NGW) {
        const int l = it / PER_L; int r = it % PER_L;
        unsigned char* wl = a.ws + WS_W + (size_t)l * WL_STRIDE;
        if (r < I_IN) { transpose_item<1>(a.in[I_WIN] + (size_t)l * DM * 11536, 11536, (bf16_t*)(wl + WL_IN), DM, r / 184, r % 184, scr, lane); continue; } r -= I_IN;
        if (r < I_GLU) { transpose_item<0>(a.in[I_WGLU] + (size_t)l * 768 * 768, 768, (bf16_t*)(wl + WL_GLU), 768, r / 12, r % 12, scr, lane); continue; } r -= I_GLU;
        if (r < I_CG) { transpose_item<0>(a.in[I_WPG] + (size_t)l * 1024 * DM, DM, (bf16_t*)(wl + WL_CAT), OCW, r / 32, r % 32, scr, lane); continue; } r -= I_CG;
        if (r < I_CS) { transpose_item<0>(a.in[I_WPS] + (size_t)l * 768 * DM, DM, (bf16_t*)(wl + WL_CAT) + 1024, OCW, r / 32, r % 32, scr, lane); continue; } r -= I_CS;
        if (r < I_CA) { transpose_item<0>(a.in[I_WPA] + (size_t)l * 1024 * DM, DM, (bf16_t*)(wl + WL_CAT) + 1792, OCW, r / 32, r % 32, scr, lane); continue; } r -= I_CA;
        if (r < I_OUT) { transpose_item<0>(a.in[I_WOUT] + (size_t)l * DM * DM, DM, (bf16_t*)(wl + WL_OUT), DM, r / 32, r % 32, scr, lane); continue; } r -= I_OUT;
        if (r < I_FFI) { transpose_item<2>(a.in[I_WFFI] + (size_t)l * DM * 2 * DFF, 2 * DFF, (bf16_t*)(wl + WL_FFI), DM, r / 176, r % 176, scr, lane); continue; } r -= I_FFI;
        transpose_item<0>(a.in[I_WFFO] + (size_t)l * DFF * DM, DM, (bf16_t*)(wl + WL_FFO), DFF, r / 32, r % 32, scr, lane);
    }
    __syncthreads();
    LAS float* SL = (LAS float*)lds;
    for (int i = tid; i < 5 * DM; i += NWAVES * 64) { const int r = i / DM, k = i % DM; const float v = r < 4 ? a.in[I_C][r * DM + k] : a.in[I_CCTX][k]; SL[i] = v / (1.0f + expf(-v)); }
    __syncthreads();
    float* MODP = (float*)(a.ws + WS_MODP);
    for (int it = gw; it < DEPTH * ADA_KS * 48; it += NGW) {
        const int l = it / (ADA_KS * 48), rem = it % (ADA_KS * 48), ks = rem / 48, nb = rem % 48;
        const float* wp = a.in[I_WADA] + ((size_t)l * DM + ks * 64) * NMOD + nb * 256 + lane * 4;
        f32x4 acc[5];
#pragma unroll
        for (int r = 0; r < 5; ++r) acc[r] = (f32x4){0.f, 0.f, 0.f, 0.f};
#pragma unroll 8
        for (int kk = 0; kk < 64; ++kk) { const f32x4 w = *(const f32x4*)(wp + (size_t)kk * NMOD); const int k = ks * 64 + kk;
#pragma unroll
            for (int r = 0; r < 5; ++r) acc[r] += w * SL[r * DM + k]; }
#pragma unroll
        for (int r = 0; r < 5; ++r) *(f32x4*)(MODP + ((size_t)((l * ADA_KS + ks) * 5 + r)) * NMOD + nb * 256 + lane * 4) = acc[r];
    }
    float* SA = (float*)(a.ws + WS_S5A); bf16_t* KB = (bf16_t*)(a.ws + WS_S5KB); bf16_t* CT = (bf16_t*)(a.ws + WS_S5CT);
    for (int i = blockIdx.x * (NWAVES * 64) + tid; i < DEPTH * 2 * 48 * 64; i += gridDim.x * NWAVES * 64) {
        const int p = i & 63, base = i >> 6, g = base % 48, l = base / 96;
        const double lre = (double)a.in[I_LAMRE][i], lim = (double)a.in[I_LAMIM][i], dt = exp((double)a.in[I_LOGDT][base]);
        const double mag = exp(lre * dt), are = mag * cos(lim * dt), aim = mag * sin(lim * dt), den = lre * lre + lim * lim;
        const double nr = are - 1.0, ni = aim, kre = (nr * lre + ni * lim) / den, kim = (ni * lre - nr * lim) / den;
        SA[2 * i] = (float)are; SA[2 * i + 1] = (float)aim;
        const float* bre = a.in[I_BRE] + ((size_t)(l * 48 + g) * 64 + p) * 16; const float* bim = a.in[I_BIM] + ((size_t)(l * 48 + g) * 64 + p) * 16;
        for (int c = 0; c < 16; ++c) { const double br = bre[c], bi = bim[c];
            KB[((size_t)base * 128 + p) * 16 + c] = f2bf((float)(kre * br - kim * bi)); KB[((size_t)base * 128 + 64 + p) * 16 + c] = f2bf((float)(kre * bi + kim * br)); }
        for (int c = 0; c < 16; ++c) { const size_t ci = ((size_t)base * 16 + c) * 64 + p;
            CT[((size_t)base * 16 + c) * 128 + p] = f2bf(a.in[I_CRE][ci]); CT[((size_t)base * 16 + c) * 128 + 64 + p] = f2bf(-a.in[I_CIM][ci]); }
    }
}
__device__ __forceinline__ void p1_mod(const Args& a) {
    const float* MODP = (const float*)(a.ws + WS_MODP); float* MOD = (float*)(a.ws + WS_MOD);
    for (int i = blockIdx.x * (NWAVES * 64) + threadIdx.x; i < DEPTH * 5 * NMOD; i += gridDim.x * NWAVES * 64) {
        const int l = i / (5 * NMOD), rem = i % (5 * NMOD), r = rem / NMOD, n = rem % NMOD;
        float s = a.in[I_BADA][l * NMOD + n];
        for (int ks = 0; ks < ADA_KS; ++ks) s += MODP[((size_t)((l * ADA_KS + ks) * 5 + r)) * NMOD + n];
        MOD[i] = s;
    }
}
__device__ __forceinline__ void p2_input(const Args& a) {
    const int tid_ = opaque(threadIdx.x), lane = tid_ & 63, wave = tid_ >> 6, gw = blockIdx.x * NWAVES + wave, NGW = gridDim.x * NWAVES;
    const float* MOD = (const float*)(a.ws + WS_MOD); float* X = (float*)(a.ws + WS_X); bf16_t* H = (bf16_t*)(a.ws + WS_H);
    for (int m = gw; m < MROWS; m += NGW) {
        const int b = m / TOK, t = m % TOK, cond = t < NCTX ? 4 : b;
        const float* src = t < NCTX ? a.in[I_CTX] + ((size_t)b * NCTX + t) * DM : a.in[I_X] + ((size_t)b * SEQ + (t - NCTX)) * DM;
        const float* sh = MOD + (size_t)cond * NMOD; const float* sc = sh + DM;
#pragma unroll
        for (int j = 0; j < 8; ++j) { const int col = lane * 4 + 256 * j; const f32x4 v = *(const f32x4*)(src + col);
            *(f32x4*)(X + (size_t)m * DM + col) = v;
            const f32x4 s1 = *(const f32x4*)(sc + col), s0 = *(const f32x4*)(sh + col); const f32x4 h = v * (1.0f + s1) + s0;
            u32x2 w; w.x = cvt_pk_bf16(h[0], h[1]); w.y = cvt_pk_bf16(h[2], h[3]); *(u32x2*)(H + (size_t)m * DM + col) = w; }
    }
}
__device__ __forceinline__ void ln_phase(const Args& a, const float* lnw, const float* lnb, const float* modp, float* out, const float* gctx, int nsl, bool skip_ctx) {
    const int tid_ = opaque(threadIdx.x), lane = tid_ & 63, wave = tid_ >> 6, gw = blockIdx.x * NWAVES + wave, NGW = gridDim.x * NWAVES;
    const float* Z = (const float*)(a.ws + WS_Z); float* X = (float*)(a.ws + WS_X); bf16_t* H = (bf16_t*)(a.ws + WS_H); const float* P = (const float*)(a.ws + WS_PART);
    for (int m = gw; m < MROWS; m += NGW) {
        const int b = m / TOK, t = m % TOK, cond = t < NCTX ? 4 : b;
        if ((out || skip_ctx) && t < NCTX) continue;
        f32x4 v[8]; float s = 0.f;
        if (t < NCTX && nsl > 0) {
#pragma unroll
            for (int j = 0; j < 8; ++j) { const int col = lane * 4 + 256 * j; f32x4 acc = (f32x4){0.f, 0.f, 0.f, 0.f};
                for (int sl = 0; sl < nsl; ++sl) acc += *(const f32x4*)(P + ((size_t)sl * 1024 + b * NCTX + t) * DM + col);
                v[j] = *(const f32x4*)(X + (size_t)m * DM + col) * DN_ALPHA + *(const f32x4*)(gctx + col) * acc; s += (v[j][0] + v[j][1]) + (v[j][2] + v[j][3]); }
        } else {
#pragma unroll
            for (int j = 0; j < 8; ++j) { v[j] = *(const f32x4*)(Z + (size_t)m * DM + lane * 4 + 256 * j); s += (v[j][0] + v[j][1]) + (v[j][2] + v[j][3]); }
        }
        const float mean = wave_sum(s) * (1.0f / DM); float q = 0.f;
#pragma unroll
        for (int j = 0; j < 8; ++j) { v[j] = v[j] - mean; q += (v[j][0] * v[j][0] + v[j][1] * v[j][1]) + (v[j][2] * v[j][2] + v[j][3] * v[j][3]); }
        const float rstd = 1.0f / sqrtf(wave_sum(q) * (1.0f / DM) + LN_EPS);
#pragma unroll
        for (int j = 0; j < 8; ++j) { const int col = lane * 4 + 256 * j;
            const f32x4 xn = v[j] * rstd * *(const f32x4*)(lnw + col) + *(const f32x4*)(lnb + col);
            if (out) { *(f32x4*)(out + ((size_t)b * SEQ + (t - NCTX)) * DM + col) = xn; }
            else { *(f32x4*)(X + (size_t)m * DM + col) = xn;
                const f32x4 s0 = *(const f32x4*)(modp + (size_t)cond * NMOD + col), s1 = *(const f32x4*)(modp + (size_t)cond * NMOD + DM + col);
                const f32x4 h = xn * (1.0f + s1) + s0; u32x2 w; w.x = cvt_pk_bf16(h[0], h[1]); w.y = cvt_pk_bf16(h[2], h[3]); *(u32x2*)(H + (size_t)m * DM + col) = w; }
        }
    }
}
__device__ __forceinline__ void merge_ctx_combine(const Args& a) {
    const int gt = blockIdx.x * (NWAVES * 64) + opaque(threadIdx.x), NT = gridDim.x * NWAVES * 64;
    const float* P = (const float*)(a.ws + WS_PART); const bf16_t* Y = (const bf16_t*)(a.ws + WS_Y); bf16_t* H = (bf16_t*)(a.ws + WS_H);
    for (int i = gt; i < 1024 * (DM / 4); i += NT) { const int r = i / (DM / 4), c = (i % (DM / 4)) * 4; const size_t m = (size_t)(r >> 8) * TOK + (r & 255);
        f32x4 sa = (f32x4){0.f, 0.f, 0.f, 0.f}, sb = sa, sc = sa;
#pragma unroll
        for (int s = 0; s < 11; ++s) { const f32x4 v = *(const f32x4*)(P + ((size_t)s * 1024 + r) * DM + c); if (s < 4) sa += v; else if (s < 7) sb += v; else sc += v; }
        const u32x2 ga = *(const u32x2*)(Y + m * YW + Y_BG + c), gb = *(const u32x2*)(Y + m * YW + Y_BG + 2048 + c), gc2 = *(const u32x2*)(Y + m * YW + Y_BG + 4096 + c);
        const float o0 = lo_bf(ga.x) * sa[0] + lo_bf(gb.x) * sb[0] + lo_bf(gc2.x) * sc[0], o1 = hi_bf(ga.x) * sa[1] + hi_bf(gb.x) * sb[1] + hi_bf(gc2.x) * sc[1];
        const float o2 = lo_bf(ga.y) * sa[2] + lo_bf(gb.y) * sb[2] + lo_bf(gc2.y) * sc[2], o3 = hi_bf(ga.y) * sa[3] + hi_bf(gb.y) * sb[3] + hi_bf(gc2.y) * sc[3];
        u32x2 w; w.x = cvt_pk_bf16(o0, o1); w.y = cvt_pk_bf16(o2, o3); *(u32x2*)(H + m * DM + c) = w; }
}
__device__ __forceinline__ void qk_phase(const Args& a, int l) {
    const int tid_ = opaque(threadIdx.x), lane = tid_ & 63, wave = tid_ >> 6, gw = blockIdx.x * NWAVES + wave, NGW = gridDim.x * NWAVES;
    const bf16_t* Y = (const bf16_t*)(a.ws + WS_Y); bf16_t* QN = (bf16_t*)(a.ws + WS_QN); bf16_t* KN = (bf16_t*)(a.ws + WS_KN);
    const float qw0 = a.in[I_QNW][l * 128 + 2 * lane], qw1 = a.in[I_QNW][l * 128 + 2 * lane + 1], kw0 = a.in[I_KNW][l * 128 + 2 * lane], kw1 = a.in[I_KNW][l * 128 + 2 * lane + 1];
    const float inv = __builtin_amdgcn_exp2f(-(float)(lane & 31) * 0.41524101186092029f);
    for (int m = gw; m < MROWS; m += NGW) {
        const int t = m % TOK; const bool lat = t >= NCTX; const int s = t - NCTX;
        float cs = 1.f, sn = 0.f;
#if defined(ABL) && ABL == 2
        if (false) {
#else
        if (lat) {
#endif
            const float pos = (lane < 32) ? (float)(s >> 6) : (float)(s & 63); const float ang = pos * inv; cs = cosf(ang); sn = sinf(ang); }
#pragma unroll
        for (int hh = 0; hh < 10; ++hh) {
            const bool isq = hh < 8;
            const unsigned pr = *(const unsigned*)(Y + (size_t)m * YW + (isq ? Y_AQ + hh * 128 : Y_AK + (hh - 8) * 128) + 2 * lane);
            float x0 = lo_bf(pr), x1 = hi_bf(pr);
            const float rstd = 1.0f / sqrtf(wave_sum(x0 * x0 + x1 * x1) * (1.0f / 128.0f) + LN_EPS);
            x0 *= rstd * (isq ? qw0 : kw0); x1 *= rstd * (isq ? qw1 : kw1);
            const float y0 = x0 * cs - x1 * sn, y1 = x0 * sn + x1 * cs;
            bf16_t* dst = isq ? QN + (size_t)m * 1024 + hh * 128 + 2 * lane : KN + (size_t)m * 256 + (hh - 8) * 128 + 2 * lane;
            *(unsigned*)dst = cvt_pk_bf16(y0, y1);
        }
    }
}
__device__ __forceinline__ void attn_unit(const Args& a, int u, char* lds) {
    const bf16_t* Y = (const bf16_t*)(a.ws + WS_Y); const bf16_t* QN = (const bf16_t*)(a.ws + WS_QN); const bf16_t* KN = (const bf16_t*)(a.ws + WS_KN); bf16_t* OC = (bf16_t*)(a.ws + WS_OCAT);
    int b, h, qrow, seq;
    if (u < 256) { const int grp = u >> 5, idx = u & 31; b = grp >> 1; h = (grp & 1) * 4 + (idx >> 3); qrow = b * TOK + NCTX + 256 * (idx & 7); seq = TOK; }
    else { const int uc = u - 256; b = uc >> 3; h = uc & 7; qrow = b * TOK; seq = NCTX; }
    const int kvh = h >> 2; const size_t krow = (size_t)b * TOK;
    __syncthreads();
    att::attn_dense_body(QN + (size_t)qrow * 1024 + h * 128, KN + krow * 256 + kvh * 128, Y + krow * YW + Y_AV + kvh * 128, OC + (size_t)qrow * OCW + 1792 + h * 128, seq, lds);
    __syncthreads();
}
__device__ __forceinline__ void gla_prep_phase(const Args& a, int l, LAS unsigned char* lds) {
    const int tid = opaque(threadIdx.x), lane = tid & 63, wave = __builtin_amdgcn_readfirstlane(tid >> 6);
    const bf16_t* Y = (const bf16_t*)(a.ws + WS_Y); const float* GLR = (const float*)(a.ws + WS_GLR);
    bf16_t* QEg = (bf16_t*)(a.ws + WS_QE); bf16_t* KEg = (bf16_t*)(a.ws + WS_KE); bf16_t* KDTg = (bf16_t*)(a.ws + WS_KDT); bf16_t* VTg = (bf16_t*)(a.ws + WS_VT); float* DECg = (float*)(a.ws + WS_DEC);
    LAS float* GL = (LAS float*)lds;
    const int dir = wave >> 2, col = (wave & 3) * 128 + 2 * lane;
    float wg0[16], wg1[16];
#pragma unroll
    for (int r = 0; r < 16; ++r) { const f32x2 w2 = *(const f32x2*)(a.in[I_WGATE] + ((size_t)(l * 2 + dir) * 16 + r) * 512 + col); wg0[r] = w2[0]; wg1[r] = w2[1]; }
    const f32x2 bg2 = *(const f32x2*)(a.in[I_BGATE] + (l * 2 + dir) * 512 + col);
    for (int gc = blockIdx.x; gc < 144; gc += gridDim.x) {
        const size_t m0 = (size_t)gc * 64;
        __syncthreads();
        if (tid < 256) *(LAS f32x4*)(GL + tid * 4) = *(const f32x4*)(GLR + m0 * 16 + tid * 4);
        __syncthreads();
#define GLA_GATE(j_, o0_, o1_) do { float p0_ = bg2[0], p1_ = bg2[1]; \
            _Pragma("unroll") for (int r4 = 0; r4 < 4; ++r4) { const f32x4 g4 = *(const LAS f32x4*)(GL + (j_) * 16 + 4 * r4); \
                p0_ += g4[0] * wg0[4 * r4] + g4[1] * wg0[4 * r4 + 1] + g4[2] * wg0[4 * r4 + 2] + g4[3] * wg0[4 * r4 + 3]; p1_ += g4[0] * wg1[4 * r4] + g4[1] * wg1[4 * r4 + 1] + g4[2] * wg1[4 * r4 + 2] + g4[3] * wg1[4 * r4 + 3]; } \
            o0_ = (fminf(p0_, 0.f) - __logf(1.0f + __expf(-fabsf(p0_)))) * (1.0f / 16.0f); o1_ = (fminf(p1_, 0.f) - __logf(1.0f + __expf(-fabsf(p1_)))) * (1.0f / 16.0f); } while (0)
        float tot0 = 0.f, tot1 = 0.f;
#pragma unroll 8
        for (int j = 0; j < 64; ++j) { float a0, a1; GLA_GATE(j, a0, a1); tot0 += a0; tot1 += a1; }
        float run0 = 0.f, run1 = 0.f;
        u32x4* dst0 = (u32x4*)(KDTg + (((size_t)dir * 144 + gc) * 512 + col) * 64); u32x4* dst1 = dst0 + 8;
        for (int hb = 0; hb < 2; ++hb) {
            unsigned qq[32], kk[32];
#pragma unroll
            for (int j = 0; j < 32; ++j) { const size_t m = m0 + hb * 32 + j; qq[j] = *(const unsigned*)(Y + m * YW + Y_GQ + col); kk[j] = *(const unsigned*)(Y + m * YW + Y_GK + col); }
#pragma unroll
            for (int q8 = 0; q8 < 4; ++q8) { unsigned kd0[4], kd1[4];
#pragma unroll
                for (int j2 = 0; j2 < 4; ++j2) { float kv0[2], kv1[2];
#pragma unroll
                    for (int e = 0; e < 2; ++e) { const int jl = 8 * q8 + 2 * j2 + e, j = hb * 32 + jl; const size_t m = m0 + j; float g0, g1; GLA_GATE(j, g0, g1);
                        const float b0 = dir == 0 ? run0 + g0 : tot0 - run0, b1 = dir == 0 ? run1 + g1 : tot1 - run1; run0 += g0; run1 += g1;
                        *(unsigned*)(QEg + ((size_t)dir * MROWS + m) * 512 + col) = cvt_pk_bf16(lo_bf(qq[jl]) * __expf(b0), hi_bf(qq[jl]) * __expf(b1));
                        *(unsigned*)(KEg + ((size_t)dir * MROWS + m) * 512 + col) = cvt_pk_bf16(lo_bf(kk[jl]) * __expf(-b0), hi_bf(kk[jl]) * __expf(-b1));
                        kv0[e] = lo_bf(kk[jl]) * __expf(tot0 - b0); kv1[e] = hi_bf(kk[jl]) * __expf(tot1 - b1); }
                    kd0[j2] = cvt_pk_bf16(kv0[0], kv0[1]); kd1[j2] = cvt_pk_bf16(kv1[0], kv1[1]); }
                dst0[hb * 4 + q8] = (u32x4){kd0[0], kd0[1], kd0[2], kd0[3]}; dst1[hb * 4 + q8] = (u32x4){kd1[0], kd1[1], kd1[2], kd1[3]}; }
        }
#undef GLA_GATE
        *(f32x2*)(DECg + ((size_t)dir * 144 + gc) * 512 + col) = (f32x2){__expf(tot0), __expf(tot1)};
        { const int v = wave * 128 + 2 * lane; unsigned v0[32], v1[32];
#pragma unroll
          for (int j2 = 0; j2 < 32; ++j2) { const unsigned a0 = *(const unsigned*)(Y + (m0 + 2 * j2) * YW + Y_GV + v), a1 = *(const unsigned*)(Y + (m0 + 2 * j2 + 1) * YW + Y_GV + v);
              v0[j2] = (a0 & 0xffffu) | (a1 << 16); v1[j2] = (a0 >> 16) | (a1 & 0xffff0000u); }
          u32x4* dst = (u32x4*)(VTg + ((size_t)gc * 1024 + v) * 64);
#pragma unroll
          for (int q8 = 0; q8 < 8; ++q8) { dst[q8] = (u32x4){v0[4 * q8], v0[4 * q8 + 1], v0[4 * q8 + 2], v0[4 * q8 + 3]}; dst[8 + q8] = (u32x4){v1[4 * q8], v1[4 * q8 + 1], v1[4 * q8 + 2], v1[4 * q8 + 3]}; } }
    }
    __syncthreads();
}
__device__ __forceinline__ bf16x8 ldsfrag(const LAS bf16_t* base, int row, int ld, int k) { return *(const LAS bf16x8*)(base + row * ld + k); }
__device__ __forceinline__ void gla_chain(const Args& a, int l, int chain, LAS unsigned char* lds) {
    const int tid = opaque(threadIdx.x), wave = __builtin_amdgcn_readfirstlane(tid >> 6), lane = tid & 63, r32 = lane & 31, hh = lane >> 5;
    const int vs = chain & 7, dir = (chain >> 3) & 1, h = (chain >> 4) & 3, b = chain >> 6;
    const bf16_t* QEg = (const bf16_t*)(a.ws + WS_QE) + (size_t)dir * MROWS * 512 + h * 128; const bf16_t* KEg = (const bf16_t*)(a.ws + WS_KE) + (size_t)dir * MROWS * 512 + h * 128;
    const bf16_t* KDTg = (const bf16_t*)(a.ws + WS_KDT) + ((size_t)dir * 144 * 512 + h * 128) * 64; const bf16_t* VTg = (const bf16_t*)(a.ws + WS_VT) + (size_t)(h * 256 + vs * 32) * 64;
    const float* DECg = (const float*)(a.ws + WS_DEC) + (size_t)dir * 144 * 512 + h * 128;
    float* OG = (float*)(a.ws + (dir ? WS_OGB : WS_OGF));
    LAS bf16_t* QE = (LAS bf16_t*)lds; LAS bf16_t* KE = QE + 64 * 136; LAS bf16_t* KDT = KE + 64 * 136; LAS bf16_t* VT = KDT + 128 * 72; LAS bf16_t* ATT = VT + 32 * 72; LAS bf16_t* ST = ATT + 64 * 72;
    LAS float* DEC = (LAS float*)(ST + 32 * 136);
    for (int i = tid; i < 32 * 136; i += NWAVES * 64) ST[i] = 0;
    f32x16 accS = {}, accO = {};
    const unsigned qsrc0 = (unsigned)((tid >> 4) * 512 + (tid & 15) * 8), qdst0 = (unsigned)((tid >> 4) * 136 + (tid & 15) * 8);
    const unsigned ksrc0 = (unsigned)((tid >> 3) * 64 + (tid & 7) * 8), kdst0 = (unsigned)((tid >> 3) * 72 + (tid & 7) * 8);
    u32x4 pq0, pq1, pk0, pk1, pd0, pd1, pv; float pdec = 0.f;
#define GLA_LOAD(ci_) do { const int ci__ = (ci_); const int c_ = dir == 0 ? ci__ : (ci__ < 4 ? 3 - ci__ : 39 - ci__); const int gc_ = b * 36 + c_; const size_t mr_ = (size_t)gc_ * 64; \
        pq0 = *(const u32x4*)(QEg + mr_ * 512 + qsrc0); pq1 = *(const u32x4*)(QEg + (mr_ + 32) * 512 + qsrc0); pk0 = *(const u32x4*)(KEg + mr_ * 512 + qsrc0); pk1 = *(const u32x4*)(KEg + (mr_ + 32) * 512 + qsrc0); \
        pd0 = *(const u32x4*)(KDTg + (size_t)gc_ * 512 * 64 + ksrc0); pd1 = *(const u32x4*)(KDTg + (size_t)gc_ * 512 * 64 + 64 * 64 + ksrc0); \
        if (tid < 256) pv = *(const u32x4*)(VTg + (size_t)gc_ * 1024 * 64 + ksrc0); if (tid < 128) pdec = DECg[(size_t)gc_ * 512 + tid]; } while (0)
    GLA_LOAD(0);
    __syncthreads();
    for (int ci = 0; ci < 36; ++ci) {
        const int c = dir == 0 ? ci : (ci < 4 ? 3 - ci : 39 - ci);
        const size_t mrow = ((size_t)b * 36 + c) * 64;
        *(LAS u32x4*)(QE + qdst0) = pq0; *(LAS u32x4*)(QE + 32 * 136 + qdst0) = pq1; *(LAS u32x4*)(KE + qdst0) = pk0; *(LAS u32x4*)(KE + 32 * 136 + qdst0) = pk1;
        *(LAS u32x4*)(KDT + kdst0) = pd0; *(LAS u32x4*)(KDT + 64 * 72 + kdst0) = pd1; if (tid < 256) *(LAS u32x4*)(VT + kdst0) = pv; if (tid < 128) DEC[tid] = pdec;
        __syncthreads();
        if (ci + 1 < 36) GLA_LOAD(ci + 1);
        if (wave < 4) {
            const int ib = wave >> 1, jb = wave & 1; f32x16 p = {};
            if ((dir == 0 && ib >= jb) || (dir == 1 && ib <= jb)) {
#pragma unroll
                for (int s = 0; s < 8; ++s) p = __builtin_amdgcn_mfma_f32_32x32x16_bf16(ldsfrag(QE, 32 * ib + r32, 136, 16 * s + 8 * hh), ldsfrag(KE, 32 * jb + r32, 136, 16 * s + 8 * hh), p, 0, 0, 0);
            }
#pragma unroll
            for (int rg = 0; rg < 16; ++rg) { const int i = 32 * ib + att::crow(rg, hh), j = 32 * jb + r32; const bool keep = dir == 0 ? (i >= j) : (i <= j); ATT[i * 72 + j] = f2bf(keep ? p[rg] : 0.f); }
        } else if (wave < 6) {
            const int ib = wave - 4; accO = (f32x16){};
#pragma unroll
            for (int s = 0; s < 8; ++s) accO = __builtin_amdgcn_mfma_f32_32x32x16_bf16(ldsfrag(QE, 32 * ib + r32, 136, 16 * s + 8 * hh), ldsfrag(ST, r32, 136, 16 * s + 8 * hh), accO, 0, 0, 0);
        }
        __syncthreads();
        if (wave < 4) {
            const int db = wave; const float dec = DEC[32 * db + r32];
#pragma unroll
            for (int rg = 0; rg < 16; ++rg) accS[rg] *= dec;
#pragma unroll
            for (int s = 0; s < 4; ++s) accS = __builtin_amdgcn_mfma_f32_32x32x16_bf16(ldsfrag(VT, r32, 72, 16 * s + 8 * hh), ldsfrag(KDT, 32 * db + r32, 72, 16 * s + 8 * hh), accS, 0, 0, 0);
#pragma unroll
            for (int rg = 0; rg < 16; ++rg) ST[att::crow(rg, hh) * 136 + 32 * db + r32] = f2bf(accS[rg]);
        } else if (wave < 6) {
            const int ib = wave - 4;
#pragma unroll
            for (int s = 0; s < 4; ++s) accO = __builtin_amdgcn_mfma_f32_32x32x16_bf16(ldsfrag(ATT, 32 * ib + r32, 72, 16 * s + 8 * hh), ldsfrag(VT, r32, 72, 16 * s + 8 * hh), accO, 0, 0, 0);
#pragma unroll
            for (int rg = 0; rg < 16; ++rg) { const int i = 32 * ib + att::crow(rg, hh); OG[(mrow + i) * 1024 + h * 256 + vs * 32 + r32] = accO[rg]; }
        }
        __syncthreads();
    }
#undef GLA_LOAD
}
template <int OFF> __device__ __forceinline__ s16x4 s5_tr_read(int vb) { s16x4 r; asm volatile("ds_read_b64_tr_b16 %0, %1 offset:%2" : "=&v"(r) : "v"(vb), "i"(OFF) : "memory"); return r; }
constexpr int S5_LDS_PER_WAVE = 128 * 20 * 4 + 128 * 16 * 2;
__device__ __forceinline__ void s5_chain(const Args& a, int l, int chain, LAS unsigned char* ldsw, int lane_in) {
    const int lane = opaque(lane_in);
    const int dir = chain & 1, g = (chain >> 1) % 48, b = chain / 96, base = (l * 2 + dir) * 48 + g;
    const bf16_t* Y = (const bf16_t*)(a.ws + WS_Y); float* YS = (float*)(a.ws + (dir ? WS_YSB : WS_YSF));
    const float* SA = (const float*)(a.ws + WS_S5A); const bf16_t* KB = (const bf16_t*)(a.ws + WS_S5KB) + (size_t)base * 128 * 16; const bf16_t* CT = (const bf16_t*)(a.ws + WS_S5CT) + (size_t)base * 16 * 128;
    LAS float* BU = (LAS float*)ldsw; LAS bf16_t* XS = (LAS bf16_t*)(ldsw + 128 * 20 * 4);
    const int lq = lane >> 4, lr = lane & 15;
    const float are = SA[2 * (base * 64 + lane)], aim = SA[2 * (base * 64 + lane) + 1];
    const bf16x8 zero8 = {0, 0, 0, 0, 0, 0, 0, 0};
    bf16x8 fb[8], fc[4];
#pragma unroll
    for (int q = 0; q < 8; ++q) fb[q] = (lq < 2) ? *(const bf16x8*)(KB + (16 * q + lr) * 16 + 8 * lq) : zero8;
#pragma unroll
    for (int s = 0; s < 4; ++s) fc[s] = *(const bf16x8*)(CT + lr * 128 + 32 * s + 8 * lq);
    const int xtr = (int)(unsigned)(size_t)XS + ((8 * lq + (lr >> 2)) * 16 + 4 * (lr & 3)) * 2;
    float xr = 0.f, xi = 0.f;
    const bf16_t* up = Y + ((size_t)b * TOK + lr) * YW + Y_SU + g * 16 + 8 * (lq & 1);
#define S5_TB(bi_) (dir == 0 ? (bi_) : ((bi_) < 16 ? 15 - (bi_) : 143 - ((bi_) - 16)))
    bf16x8 un = *(const bf16x8*)(up + (size_t)S5_TB(0) * 16 * YW);
    for (int bi = 0; bi < 144; ++bi) {
        const int tb = S5_TB(bi);
        const size_t row0 = (size_t)b * TOK + tb * 16;
#if defined(ABL) && ABL == 4
        if (bi == 16) { xr = 0.f; xi = 0.f; }
#endif
        const bf16x8 ua = (lq < 2) ? un : zero8;
        if (bi + 1 < 144) un = *(const bf16x8*)(up + (size_t)S5_TB(bi + 1) * 16 * YW);
#pragma unroll
        for (int q = 0; q < 8; ++q) { const f32x4 r = __builtin_amdgcn_mfma_f32_16x16x32_bf16(ua, fb[q], (f32x4){0.f, 0.f, 0.f, 0.f}, 0, 0, 0); *(LAS f32x4*)(BU + (16 * q + lr) * 20 + 4 * lq) = r; }
        LDS_WAIT();
        f32x4 br[4], bim[4];
#pragma unroll
        for (int g4 = 0; g4 < 4; ++g4) { br[g4] = *(const LAS f32x4*)(BU + lane * 20 + 4 * g4); bim[g4] = *(const LAS f32x4*)(BU + (64 + lane) * 20 + 4 * g4); }
        float xrs[16], xis[16];
        if (dir == 0) {
#pragma unroll
            for (int t = 0; t < 16; ++t) { const float nr = are * xr - aim * xi + br[t >> 2][t & 3], ni = are * xi + aim * xr + bim[t >> 2][t & 3]; xr = nr; xi = ni; xrs[t] = xr; xis[t] = xi; }
        } else {
#pragma unroll
            for (int t = 15; t >= 0; --t) { const float nr = are * xr - aim * xi + br[t >> 2][t & 3], ni = are * xi + aim * xr + bim[t >> 2][t & 3]; xr = nr; xi = ni; xrs[t] = xr; xis[t] = xi; }
        }
        { u32x4 w0, w1;
          w0.x = cvt_pk_bf16(xrs[0], xrs[1]); w0.y = cvt_pk_bf16(xrs[2], xrs[3]); w0.z = cvt_pk_bf16(xrs[4], xrs[5]); w0.w = cvt_pk_bf16(xrs[6], xrs[7]);
          w1.x = cvt_pk_bf16(xrs[8], xrs[9]); w1.y = cvt_pk_bf16(xrs[10], xrs[11]); w1.z = cvt_pk_bf16(xrs[12], xrs[13]); w1.w = cvt_pk_bf16(xrs[14], xrs[15]);
          *(LAS u32x4*)(XS + lane * 16) = w0; *(LAS u32x4*)(XS + lane * 16 + 8) = w1;
          w0.x = cvt_pk_bf16(xis[0], xis[1]); w0.y = cvt_pk_bf16(xis[2], xis[3]); w0.z = cvt_pk_bf16(xis[4], xis[5]); w0.w = cvt_pk_bf16(xis[6], xis[7]);
          w1.x = cvt_pk_bf16(xis[8], xis[9]); w1.y = cvt_pk_bf16(xis[10], xis[11]); w1.z = cvt_pk_bf16(xis[12], xis[13]); w1.w = cvt_pk_bf16(xis[14], xis[15]);
          *(LAS u32x4*)(XS + (64 + lane) * 16) = w0; *(LAS u32x4*)(XS + (64 + lane) * 16 + 8) = w1; }
        LDS_WAIT();
        const s16x4 t00 = s5_tr_read<(0 * 32 + 0) * 32>(xtr), t01 = s5_tr_read<(0 * 32 + 4) * 32>(xtr), t10 = s5_tr_read<(1 * 32 + 0) * 32>(xtr), t11 = s5_tr_read<(1 * 32 + 4) * 32>(xtr);
        const s16x4 t20 = s5_tr_read<(2 * 32 + 0) * 32>(xtr), t21 = s5_tr_read<(2 * 32 + 4) * 32>(xtr), t30 = s5_tr_read<(3 * 32 + 0) * 32>(xtr), t31 = s5_tr_read<(3 * 32 + 4) * 32>(xtr);
        asm volatile("s_waitcnt lgkmcnt(0)" ::: "memory"); __builtin_amdgcn_sched_barrier(0);
#define S5PK(L, H) (bf16x8){L[0], L[1], L[2], L[3], H[0], H[1], H[2], H[3]}
        f32x4 yo = {0.f, 0.f, 0.f, 0.f};
        yo = __builtin_amdgcn_mfma_f32_16x16x32_bf16(fc[0], S5PK(t00, t01), yo, 0, 0, 0); yo = __builtin_amdgcn_mfma_f32_16x16x32_bf16(fc[1], S5PK(t10, t11), yo, 0, 0, 0);
        yo = __builtin_amdgcn_mfma_f32_16x16x32_bf16(fc[2], S5PK(t20, t21), yo, 0, 0, 0); yo = __builtin_amdgcn_mfma_f32_16x16x32_bf16(fc[3], S5PK(t30, t31), yo, 0, 0, 0);
#undef S5PK
        *(f32x4*)(YS + (row0 + lr) * 768 + g * 16 + 4 * lq) = yo;
        LDS_WAIT();
    }
#undef S5_TB
}
__device__ __forceinline__ void postmix_phase(const Args& a, int l, bool skip_ctx) {
    const int tid_ = opaque(threadIdx.x), lane = tid_ & 63, wave = tid_ >> 6, gw = blockIdx.x * NWAVES + wave, NGW = gridDim.x * NWAVES;
    const bf16_t* Y = (const bf16_t*)(a.ws + WS_Y); bf16_t* OC = (bf16_t*)(a.ws + WS_OCAT); bf16_t* YG = (bf16_t*)(a.ws + WS_YG);
    const float* OGF = (const float*)(a.ws + WS_OGF); const float* OGB = (const float*)(a.ws + WS_OGB); const float* YSF = (const float*)(a.ws + WS_YSF); const float* YSB = (const float*)(a.ws + WS_YSB);
    for (int m = gw; m < MROWS; m += NGW) {
        if (skip_ctx && (m % TOK) < NCTX) continue;
#pragma unroll
        for (int h = 0; h < 4; ++h) { const int col = h * 256 + lane * 4;
            f32x4 o = *(const f32x4*)(OGF + (size_t)m * 1024 + col) + *(const f32x4*)(OGB + (size_t)m * 1024 + col);
            const float mean = wave_sum((o[0] + o[1]) + (o[2] + o[3])) * (1.0f / 256.0f); o = o - mean;
            const float rstd = 1.0f / sqrtf(wave_sum((o[0] * o[0] + o[1] * o[1]) + (o[2] * o[2] + o[3] * o[3])) * (1.0f / 256.0f) + LN_EPS);
            const f32x4 w = *(const f32x4*)(a.in[I_GLANW] + l * 1024 + col); const u32x2 gr = *(const u32x2*)(Y + (size_t)m * YW + Y_GR + col);
            o = o * rstd * w; u32x2 ov; ov.x = cvt_pk_bf16(o[0] * lo_bf(gr.x), o[1] * hi_bf(gr.x)); ov.y = cvt_pk_bf16(o[2] * lo_bf(gr.y), o[3] * hi_bf(gr.y));
            *(u32x2*)(OC + (size_t)m * OCW + col) = ov; }
#pragma unroll
        for (int j = 0; j < 3; ++j) { const int col = j * 256 + lane * 4;
            const u32x2 su = *(const u32x2*)(Y + (size_t)m * YW + Y_SU + col); const f32x4 dsk = *(const f32x4*)(a.in[I_S5D] + l * 768 + col);
            f32x4 y = *(const f32x4*)(YSF + (size_t)m * 768 + col) + *(const f32x4*)(YSB + (size_t)m * 768 + col);
#if defined(ABL) && ABL == 3
            y = (f32x4){0.f, 0.f, 0.f, 0.f};
#endif
            y[0] += lo_bf(su.x) * dsk[0]; y[1] += hi_bf(su.x) * dsk[1]; y[2] += lo_bf(su.y) * dsk[2]; y[3] += hi_bf(su.y) * dsk[3];
            u32x2 ov; ov.x = cvt_pk_bf16(fgelu_tanh(y[0]), fgelu_tanh(y[1])); ov.y = cvt_pk_bf16(fgelu_tanh(y[2]), fgelu_tanh(y[3]));
            *(u32x2*)(YG + (size_t)m * 768 + col) = ov; }
    }
}
#ifdef DIAG
constexpr size_t WS_DIAG = 512 * 1024;
__device__ __forceinline__ void diag_max(const Args& a, int k, float err) { if (!(err >= 0.f)) err = 9e9f; atomicMax((unsigned*)(a.ws + WS_DIAG) + k, __float_as_uint(err)); }
__device__ __forceinline__ unsigned dhash(unsigned x) { x ^= x >> 16; x *= 0x7feb352dU; x ^= x >> 15; x *= 0x846ca68bU; x ^= x >> 16; return x; }
__device__ __forceinline__ double ddot(const bf16_t* A, const bf16_t* B, int K) { double s = 0; for (int k = 0; k < K; ++k) s += (double)bf2f(A[k]) * (double)bf2f(B[k]); return s; }
__device__ __forceinline__ float relerr(float got, float ref, float floor_) { return fabsf(got - ref) / (fabsf(ref) + floor_); }
#define DIAG_NS 2048
#ifndef GLA_CHK_HI
#define GLA_CHK_HI 100000
#endif
#ifndef GLA_CHK_LO
#define GLA_CHK_LO 0
#endif
#ifndef GLA_CHK_DIR
#define GLA_CHK_DIR -1
#endif
#ifndef DIAG_LIMIT
#define DIAG_LIMIT 0.04f
#endif
#ifndef DIAG_LAYER
#define DIAG_LAYER 0
#endif
__device__ __forceinline__ void diag_check(const Args& a, int l, int which) {
    const int gt = blockIdx.x * (NWAVES * 64) + opaque(threadIdx.x), NT = gridDim.x * NWAVES * 64;
    unsigned char* ws = a.ws; unsigned char* wl = ws + WS_W + (size_t)l * WL_STRIDE;
    const bf16_t* H = (const bf16_t*)(ws + WS_H); const bf16_t* Y = (const bf16_t*)(ws + WS_Y); const float* GLR = (const float*)(ws + WS_GLR);
    const bf16_t* OC = (const bf16_t*)(ws + WS_OCAT); const bf16_t* YG = (const bf16_t*)(ws + WS_YG); const float* X = (const float*)(ws + WS_X); const float* Z = (const float*)(ws + WS_Z);
    const float* MOD = (const float*)(ws + WS_MOD) + (size_t)l * 5 * NMOD;
    if (which == 1) {
        const bf16_t* W = (const bf16_t*)(wl + WL_IN);
        for (int s = gt; s < DIAG_NS; s += NT) { const unsigned hx = dhash(s * 2654435761u + 17u); const int row = hx % MROWS; int n = (hx >> 13) % 11536; if ((s & 15) == 0) n = 11520 + (hx >> 9) % 16;
            const float d = (float)ddot(H + (size_t)row * DM, W + (size_t)n * DM, DM); float got; float ref = d;
            if (n >= 11520) got = GLR[(size_t)row * 16 + (n - 11520)];
            else { got = bf2f(Y[(size_t)row * YW + n]); if (n < 512) ref = d * 0.08838834764831845f; else if (n >= 2048 && n < 3072) ref = d / (1.0f + expf(-(float)d)); else if (n >= 5376) ref = 1.0f / (1.0f + expf(-(float)d)); }
            diag_max(a, 1, relerr(got, ref, 0.05f)); }
    }
    if (which == 2) {
        const float* OGF = (const float*)(ws + WS_OGF); const float* OGB = (const float*)(ws + WS_OGB); const float* YSF = (const float*)(ws + WS_YSF); const float* YSB = (const float*)(ws + WS_YSB);
        for (int s = gt; s < DIAG_NS; s += NT) { const unsigned hx = dhash(s * 2654435761u + 29u); const int row = hx % MROWS, c = (hx >> 14) % 1024, h = c >> 8;
            float mu = 0, var = 0; for (int v = 0; v < 256; ++v) mu += OGF[(size_t)row * 1024 + h * 256 + v] + OGB[(size_t)row * 1024 + h * 256 + v]; mu /= 256;
            for (int v = 0; v < 256; ++v) { const float o = OGF[(size_t)row * 1024 + h * 256 + v] + OGB[(size_t)row * 1024 + h * 256 + v] - mu; var += o * o; } var /= 256;
            const float o = OGF[(size_t)row * 1024 + c] + OGB[(size_t)row * 1024 + c];
            const float ref = (o - mu) / sqrtf((float)(var + 1e-6)) * a.in[I_GLANW][l * 1024 + c] * bf2f(Y[(size_t)row * YW + Y_GR + c]);
            diag_max(a, 2, relerr(bf2f(OC[(size_t)row * OCW + c]), ref, 0.05f));
            const int c2 = (hx >> 10) % 768; float y = YSF[(size_t)row * 768 + c2] + YSB[(size_t)row * 768 + c2] + bf2f(Y[(size_t)row * YW + Y_SU + c2]) * a.in[I_S5D][l * 768 + c2];
            const float g = 0.5f * y * (1.0f + tanhf((float)(0.7978845608028654f * (y + 0.044715f * y * y * y))));
            diag_max(a, 2, relerr(bf2f(YG[(size_t)row * 768 + c2]), g, 0.05f)); }
    }
    if (which == 3) {
        const bf16_t* W = (const bf16_t*)(wl + WL_GLU);
        for (int s = gt; s < DIAG_NS; s += NT) { const unsigned hx = dhash(s * 2654435761u + 31u); const int row = hx % MROWS, c = (hx >> 14) % 768;
            const float d = (float)ddot(YG + (size_t)row * 768, W + (size_t)c * 768, 768); const float ref = bf2f(YG[(size_t)row * 768 + c]) / (1.0f + expf(-(float)d));
            diag_max(a, 3, relerr(bf2f(OC[(size_t)row * OCW + 1024 + c]), ref, 0.03f)); }
    }
    if (which == 4) {
        const bf16_t* W = (const bf16_t*)(wl + WL_CAT);
        for (int s = gt; s < DIAG_NS; s += NT) { const unsigned hx = dhash(s * 2654435761u + 37u); const int row = hx % MROWS, c = (hx >> 14) % DM;
            const float pa = (float)ddot(OC + (size_t)row * OCW, W + (size_t)c * OCW, 1024), pb = (float)ddot(OC + (size_t)row * OCW + 1024, W + (size_t)c * OCW + 1024, 768), pc = (float)ddot(OC + (size_t)row * OCW + 1792, W + (size_t)c * OCW + 1792, 1024);
            const float ref = pa * bf2f(Y[(size_t)row * YW + Y_BG + c]) + pb * bf2f(Y[(size_t)row * YW + Y_BG + 2048 + c]) + pc * bf2f(Y[(size_t)row * YW + Y_BG + 4096 + c]);
            diag_max(a, 4, relerr(bf2f(H[(size_t)row * DM + c]), ref, 0.03f)); }
    }
    if (which == 5 || which == 8) {
        const bool ffn = which == 8; const bf16_t* W = (const bf16_t*)(wl + (ffn ? WL_FFO : WL_OUT)); const bf16_t* A = ffn ? Y : H; const int K = ffn ? DFF : DM;
        for (int s = gt; s < DIAG_NS; s += NT) { const unsigned hx = dhash(s * 2654435761u + 41u); const int row = hx % MROWS, c = (hx >> 14) % DM; const int t = row % TOK, cond = t < NCTX ? 4 : row / TOK;
            const float d = (float)ddot(A + (size_t)row * K, W + (size_t)c * K, K); const float ref = DN_ALPHA * X[(size_t)row * DM + c] + MOD[(size_t)cond * NMOD + (ffn ? 5 : 2) * DM + c] * d;
            diag_max(a, which, relerr(Z[(size_t)row * DM + c], ref, 0.02f)); }
    }
    if (which == 6 || which == 9) {
        const bool second = which == 9; const float* lw = a.in[second ? I_LN2W : I_LN1W] + l * DM; const float* lb = a.in[second ? I_LN2B : I_LN1B] + l * DM;
        const float* mp = second ? (const float*)(ws + WS_MOD) + (size_t)(l + 1) * 5 * NMOD : MOD + 3 * DM;
        for (int s = gt; s < 256; s += NT) { const unsigned hx = dhash(s * 2654435761u + 43u); const int row = hx % MROWS, c = (hx >> 14) % DM; const int t = row % TOK, cond = t < NCTX ? 4 : row / TOK;
            float mu = 0, var = 0; for (int k = 0; k < DM; ++k) mu += Z[(size_t)row * DM + k]; mu /= DM; for (int k = 0; k < DM; ++k) { const float dd = Z[(size_t)row * DM + k] - mu; var += dd * dd; } var /= DM;
            const float xn = (Z[(size_t)row * DM + c] - mu) / sqrtf((float)(var + 1e-6)) * lw[c] + lb[c];
            diag_max(a, which, relerr(X[(size_t)row * DM + c], xn, 0.02f));
            if (!(second && l + 1 == DEPTH)) { const float hh = xn * (1.0f + mp[(size_t)cond * NMOD + DM + c]) + mp[(size_t)cond * NMOD + c]; diag_max(a, which, relerr(bf2f(H[(size_t)row * DM + c]), hh, 0.03f)); } }
    }
    if (which == 7) {
        const bf16_t* W = (const bf16_t*)(wl + WL_FFI);
        for (int s = gt; s < DIAG_NS; s += NT) { const unsigned hx = dhash(s * 2654435761u + 47u); const int row = hx % MROWS, j = (hx >> 14) % DFF; const int na = (j >> 7) * 256 + (j & 127), nb = na + 128;
            const float da = (float)ddot(H + (size_t)row * DM, W + (size_t)na * DM, DM), db = (float)ddot(H + (size_t)row * DM, W + (size_t)nb * DM, DM); const float ref = da / (1.0f + expf(-(float)da)) * db;
            diag_max(a, 7, relerr(bf2f(Y[(size_t)row * DFF + j]), ref, 0.03f)); }
    }
}
__device__ __forceinline__ void diag_report(const Args& a) {
    if (blockIdx.x == 0 && threadIdx.x == 0) { const unsigned* d = (const unsigned*)(a.ws + WS_DIAG); float code = 0.f;
        for (int k = 1; k <= 9; ++k) { const float e = __uint_as_float(__hip_atomic_load(d + k, __ATOMIC_RELAXED, __HIP_MEMORY_SCOPE_AGENT)); if (e > DIAG_LIMIT) { int lvl = (int)(e * 20.f); lvl = lvl > 9 ? 9 : lvl; code = (float)((10 * k + lvl) * 100); break; } }
        if (code > 0.f) a.out[0] = code; }
}
#endif
#ifdef DIAG
__device__ __forceinline__ void diag_check2(const Args& a, int l, int which) {
    const int tid = opaque(threadIdx.x), lane = tid & 63, gwv = blockIdx.x * NWAVES + (tid >> 6), gt = blockIdx.x * (NWAVES * 64) + tid, NT = gridDim.x * NWAVES * 64;
    unsigned char* ws = a.ws; const bf16_t* Y = (const bf16_t*)(ws + WS_Y);
    if (which == 1) {
        const float* MOD = (const float*)(ws + WS_MOD);
        for (int s = gt; s < 1024; s += NT) { const unsigned hx = dhash(s * 2654435761u + 53u); const int ll = hx & 3, r = (hx >> 2) % 5, n = (hx >> 8) % NMOD; float acc = a.in[I_BADA][ll * NMOD + n];
            for (int k = 0; k < DM; ++k) { const float v = r < 4 ? a.in[I_C][r * DM + k] : a.in[I_CCTX][k]; acc += (v / (1.0f + expf(-v))) * a.in[I_WADA][((size_t)ll * DM + k) * NMOD + n]; }
            diag_max(a, 1, relerr(MOD[((size_t)ll * 5 + r) * NMOD + n], (float)acc, 0.01f)); }
    }
    if (which == 2) {
        for (int s = gt; s < 8192; s += NT) { const unsigned hx = dhash(s * 2654435761u + 59u); const int ll = hx & 3, mat = (hx >> 2) % 8; const unsigned h2 = dhash(hx); unsigned char* wl = ws + WS_W + (size_t)ll * WL_STRIDE;
            float src = 0.f; bf16_t got = 0;
            if (mat == 0) { const int n = h2 % NIN, k = (h2 >> 14) % DM; const int sc = map_col<1>(n); src = sc >= 0 ? a.in[I_WIN][((size_t)ll * DM + k) * 11536 + sc] : 0.f; got = ((const bf16_t*)(wl + WL_IN))[(size_t)n * DM + k]; }
            else if (mat == 1) { const int n = h2 % 768, k = (h2 >> 14) % 768; src = a.in[I_WGLU][((size_t)ll * 768 + k) * 768 + n]; got = ((const bf16_t*)(wl + WL_GLU))[(size_t)n * 768 + k]; }
            else if (mat == 2) { const int n = h2 % DM, k = (h2 >> 14) % 1024; src = a.in[I_WPG][((size_t)ll * 1024 + k) * DM + n]; got = ((const bf16_t*)(wl + WL_CAT))[(size_t)n * OCW + k]; }
            else if (mat == 3) { const int n = h2 % DM, k = (h2 >> 14) % 768; src = a.in[I_WPS][((size_t)ll * 768 + k) * DM + n]; got = ((const bf16_t*)(wl + WL_CAT))[(size_t)n * OCW + 1024 + k]; }
            else if (mat == 4) { const int n = h2 % DM, k = (h2 >> 14) % 1024; src = a.in[I_WPA][((size_t)ll * 1024 + k) * DM + n]; got = ((const bf16_t*)(wl + WL_CAT))[(size_t)n * OCW + 1792 + k]; }
            else if (mat == 5) { const int n = h2 % DM, k = (h2 >> 14) % DM; src = a.in[I_WOUT][((size_t)ll * DM + k) * DM + n]; got = ((const bf16_t*)(wl + WL_OUT))[(size_t)n * DM + k]; }
            else if (mat == 6) { const int n = h2 % (2 * DFF), k = (h2 >> 14) % DM; src = a.in[I_WFFI][((size_t)ll * DM + k) * (2 * DFF) + map_col<2>(n)]; got = ((const bf16_t*)(wl + WL_FFI))[(size_t)n * DM + k]; }
            else { const int n = h2 % DM, k = (h2 >> 12) % DFF; src = a.in[I_WFFO][((size_t)ll * DFF + k) * DM + n]; got = ((const bf16_t*)(wl + WL_FFO))[(size_t)n * DFF + k]; }
            diag_max(a, 2, (got == f2bf(src)) ? 0.f : 1.f); }
    }
    if (which == 3) {
        const bf16_t* QN = (const bf16_t*)(ws + WS_QN); const bf16_t* KN = (const bf16_t*)(ws + WS_KN);
        for (int s = gt; s < 2048; s += NT) { const unsigned hx = dhash(s * 2654435761u + 61u); const int m = hx % MROWS, hh = (hx >> 14) % 10, e = (hx >> 18) % 128; const int t = m % TOK; const bool isq = hh < 8;
            const bf16_t* src = Y + (size_t)m * YW + (isq ? Y_AQ + hh * 128 : Y_AK + (hh - 8) * 128); const float* w = a.in[isq ? I_QNW : I_KNW] + l * 128;
            float ss = 0.f; for (int i = 0; i < 128; ++i) { const float x = bf2f(src[i]); ss += x * x; } const float rstd = 1.0f / sqrtf(ss / 128.0f + 1e-6f);
            const int pi = e >> 1; const float x0 = bf2f(src[2 * pi]) * rstd * w[2 * pi], x1 = bf2f(src[2 * pi + 1]) * rstd * w[2 * pi + 1]; float ref;
            if (t >= NCTX) { const int sl = t - NCTX; const float pos = pi < 32 ? (float)(sl / 64) : (float)(sl % 64); const float ang = pos * powf(10000.0f, -(float)(pi & 31) / 32.0f); ref = (e & 1) ? x0 * sinf(ang) + x1 * cosf(ang) : x0 * cosf(ang) - x1 * sinf(ang); }
            else ref = (e & 1) ? x1 : x0;
            const float got = bf2f(isq ? QN[(size_t)m * 1024 + hh * 128 + e] : KN[(size_t)m * 256 + (hh - 8) * 128 + e]);
            diag_max(a, 3, relerr(got, ref, 0.05f)); }
    }
    if (which == 4) {
        const bf16_t* QN = (const bf16_t*)(ws + WS_QN); const bf16_t* KN = (const bf16_t*)(ws + WS_KN); const bf16_t* OC = (const bf16_t*)(ws + WS_OCAT);
        for (int s = gwv; s < 96; s += gridDim.x * NWAVES) { const unsigned hx = dhash(s * 2654435761u + 67u); int m = hx % MROWS; if (s < 16) m = (m / TOK) * TOK + (m % NCTX); const int h = (hx >> 14) & 7, kvh = h >> 2; const int t = m % TOK, b = m / TOK;
            const int nk = t < NCTX ? NCTX : TOK; const size_t kr0 = (size_t)b * TOK; float sc[36]; float mx = -1e30f;
#pragma unroll
            for (int i = 0; i < 36; ++i) { const int j = lane + 64 * i; float d = -1e30f; if (j < nk) { d = 0.f; for (int e = 0; e < 128; ++e) d += bf2f(QN[(size_t)m * 1024 + h * 128 + e]) * bf2f(KN[(kr0 + j) * 256 + kvh * 128 + e]); d *= 0.08838834764831845f; } sc[i] = d; mx = fmaxf(mx, d); }
#pragma unroll
            for (int o = 1; o < 64; o <<= 1) mx = fmaxf(mx, __shfl_xor(mx, o));
            float sum = 0.f;
#pragma unroll
            for (int i = 0; i < 36; ++i) { sc[i] = (lane + 64 * i < nk) ? expf(sc[i] - mx) : 0.f; sum += sc[i]; }
            sum = wave_sum(sum); float worst = 0.f;
            for (int e = 0; e < 128; ++e) { float acc = 0.f;
#pragma unroll
                for (int i = 0; i < 36; ++i) { const int j = lane + 64 * i; if (j < nk) acc += sc[i] * bf2f(Y[(kr0 + j) * YW + Y_AV + kvh * 128 + e]); }
                acc = wave_sum(acc) / sum; worst = fmaxf(worst, relerr(bf2f(OC[(size_t)m * OCW + 1792 + h * 128 + e]), acc, 0.03f)); }
            if (lane == 0) diag_max(a, 4, worst); }
    }
    if (which == 5) {
        for (int s = gwv; s < 24; s += gridDim.x * NWAVES) { const unsigned hx = dhash(s * 2654435761u + 71u); const int dir = s & 1, g = (hx >> 3) % 48, b = (hx >> 12) & 3, base = (l * 2 + dir) * 48 + g;
            const float* YS = (const float*)(ws + (dir ? WS_YSB : WS_YSF));
            const float lre = a.in[I_LAMRE][base * 64 + lane], lim = a.in[I_LAMIM][base * 64 + lane], dt = expf(a.in[I_LOGDT][base]);
            const float mag = expf(lre * dt), ared = mag * cosf(lim * dt), aimd = mag * sinf(lim * dt), den = lre * lre + lim * lim, nr = ared - 1.0f, ni = aimd; const float kre = ((nr * lre + ni * lim) / den), kim = ((ni * lre - nr * lim) / den), are = ared, aim = aimd;
            const float* bre = a.in[I_BRE] + ((size_t)(l * 48 + g) * 64 + lane) * 16; const float* bim = a.in[I_BIM] + ((size_t)(l * 48 + g) * 64 + lane) * 16;
            float xr = 0.f, xi = 0.f, sd = 0.f, sr = 0.f;
            for (int st = 0; st < TOK; ++st) { const int t = dir == 0 ? st : (st < NCTX ? NCTX - 1 - st : TOK - 1 - (st - NCTX)); const size_t m = (size_t)b * TOK + t;
                float ur = 0.f, ui = 0.f; for (int c = 0; c < 16; ++c) { const float u = bf2f(Y[m * YW + Y_SU + g * 16 + c]); ur += bre[c] * u; ui += bim[c] * u; }
                const float inr = kre * ur - kim * ui, ini = kre * ui + kim * ur; const float n0 = are * xr - aim * xi + inr, n1 = are * xi + aim * xr + ini; xr = n0; xi = n1;
                if ((st & 7) == 3 || st == NCTX || st == TOK - 1) { for (int c = 0; c < 16; ++c) { const size_t ci = ((size_t)base * 16 + c) * 64 + lane; const float y = wave_sum(a.in[I_CRE][ci] * xr - a.in[I_CIM][ci] * xi); const float df = YS[m * 768 + g * 16 + c] - y; sd += df * df; sr += y * y; } } }
            if (lane == 0) diag_max(a, 5, sqrtf(sd / (sr + 1e-12f))); }
    }
    if (which == 6) {
        const float* GLR = (const float*)(ws + WS_GLR);
        for (int s = gwv; s < 24; s += gridDim.x * NWAVES) { const unsigned hx = dhash(s * 2654435761u + 73u); const int dir = s & 1, h = (hx >> 3) & 3, b = (hx >> 6) & 3, v = (hx >> 9) & 255;
            const float* OG = (const float*)(ws + (dir ? WS_OGB : WS_OGF)); float wg0[16], wg1[16];
#pragma unroll
            for (int r = 0; r < 16; ++r) { wg0[r] = a.in[I_WGATE][((size_t)(l * 2 + dir) * 16 + r) * 512 + h * 128 + 2 * lane]; wg1[r] = a.in[I_WGATE][((size_t)(l * 2 + dir) * 16 + r) * 512 + h * 128 + 2 * lane + 1]; }
            const float bg0 = a.in[I_BGATE][(l * 2 + dir) * 512 + h * 128 + 2 * lane], bg1 = a.in[I_BGATE][(l * 2 + dir) * 512 + h * 128 + 2 * lane + 1];
            float s0 = 0.f, s1 = 0.f, sd = 0.f, sr = 0.f;
            for (int st = 0; st < TOK; ++st) { const int t = dir == 0 ? st : (st < NCTX ? NCTX - 1 - st : TOK - 1 - (st - NCTX)); const size_t m = (size_t)b * TOK + t;
                float p0 = bg0, p1 = bg1;
#pragma unroll
                for (int r = 0; r < 16; ++r) { const float gl = GLR[m * 16 + r]; p0 += gl * wg0[r]; p1 += gl * wg1[r]; }
                const float a0 = expf((fminf(p0, 0.f) - log1pf(expf(-fabsf(p0)))) / 16.0f), a1 = expf((fminf(p1, 0.f) - log1pf(expf(-fabsf(p1)))) / 16.0f);
                const float vv = bf2f(Y[m * YW + Y_GV + h * 256 + v]); const unsigned kq = *(const unsigned*)(Y + m * YW + Y_GK + h * 128 + 2 * lane), qq = *(const unsigned*)(Y + m * YW + Y_GQ + h * 128 + 2 * lane);
                s0 = a0 * s0 + lo_bf(kq) * vv; s1 = a1 * s1 + hi_bf(kq) * vv;
                const float o = wave_sum(lo_bf(qq) * s0 + hi_bf(qq) * s1);
                if (((st & 3) == 1 || st == NCTX) && st < GLA_CHK_HI && st >= GLA_CHK_LO && (GLA_CHK_DIR < 0 || dir == GLA_CHK_DIR)) { const float df = OG[m * 1024 + h * 256 + v] - o; sd += df * df; sr += o * o; } }
            if (lane == 0) diag_max(a, 6, sqrtf(sd / (sr + 1e-12f))); }
    }
}
#endif
__global__ void __launch_bounds__(NWAVES * 64, 2) fwd_kernel(Args args) {
    extern __shared__ __attribute__((aligned(16))) unsigned char lds_raw[];
    LAS unsigned char* lds = (LAS unsigned char*)lds_raw;
    const int tid = threadIdx.x, wave = __builtin_amdgcn_readfirstlane(tid >> 6), lane = tid & 63;
    const int G = gridDim.x;
    unsigned char* ws = args.ws;
    for (int u = tid; u < (LDS_BYTES - LDSCTL_OFF) / 4; u += NWAVES * 64) ((LAS unsigned*)(lds + LDSCTL_OFF))[u] = 0u;
    __syncthreads();
    const int lo = args.ph_lo, hi = args.ph_hi;
    XcdBarrier bar; bar.bar = (unsigned*)(ws + WS_CTL) + CW_BAR; bar.x = 0; bar.st = nullptr;
    if (hi - lo > 1) bar = xcd_barrier_post((unsigned*)(ws + WS_CTL) + CW_BAR, (volatile LAS unsigned*)(lds + MISC_OFF) + 8);
#ifndef PHMASK
#define PHMASK 0xFFFF
#endif
#define IN(k) (lo <= (k) && (k) < hi)
#ifndef GEMM_SP2
#define GEMM_SP2 true
#endif
#ifndef GEMM_ALIGN
#define GEMM_ALIGN true
#endif
#ifndef PREPREP
#define PREPREP 0
#endif
#ifndef REPEAT_MASK
#define REPEAT_MASK 0
#endif
#define REPS(j) ((((REPEAT_MASK) >> (j)) & 1) ? 2 : 1)
#define INL(j) ((((PHMASK) >> (j)) & 1) && IN(pb + (j)))
#define INP(j) ((((PHMASK) >> (11 + (j))) & 1) && IN(j))
#define SEAM(k) do { if (IN((k) + 1)) xcd_barrier(bar); } while (0)
#ifdef DIAG
#ifndef DIAG_MASK
#define DIAG_MASK 0x3FE
#endif
#define DCHK(id) do { if (((DIAG_MASK) >> (id)) & 1) { if (l == DIAG_LAYER) { diag_check(pa, l, id); xcd_barrier(bar); } } } while (0)
#else
#define DCHK(id) do { } while (0)
#endif

    if (INP(0)) for (int rep_ = 0; rep_ < REPS(11); ++rep_) { p0_prologue(args, lds); SEAM(0); }
    if (INP(1)) for (int rep_ = 0; rep_ < REPS(12); ++rep_) { p1_mod(args); SEAM(1); }
    if (INP(2)) for (int rep_ = 0; rep_ < REPS(13); ++rep_) { p2_input(args); SEAM(2); }
#if defined(DIAG) && defined(DIAG2_MASK)
    if ((DIAG2_MASK >> 1) & 1) { diag_check2(args, 0, 1); xcd_barrier(bar); }
    if ((DIAG2_MASK >> 2) & 1) { diag_check2(args, 0, 2); xcd_barrier(bar); }
#endif

    for (int l = 0; l < DEPTH; ++l) {
        const int pb = NPH_PRO + l * NPH_LAYER; const bool last = (l == DEPTH - 1);
#define PHASE_ENV unsigned char* ws = opaque_ptr(args.ws); Args pa = args; pa.ws = ws; unsigned char* wl = ws + WS_W + (size_t)l * WL_STRIDE; const float* MOD = (const float*)(ws + WS_MOD); const float* modl = MOD + (size_t)l * 5 * NMOD; (void)wl; (void)modl; (void)MOD
        if (INL(0)) for (int rep_ = 0; rep_ < REPS(0); ++rep_) { PHASE_ENV;
            pg8::Gemm g{(const bf16_t*)(ws + WS_H), (const bf16_t*)(wl + WL_IN), MROWS, NIN, DM, DM, DM}; pg8::Order S; S.init_all(MROWS, NIN, DM, G, (int)blockIdx.x);
            pg8::EpiInProj E{(bf16_t*)(ws + WS_Y), (float*)(ws + WS_GLR)};
            pg8::gemm_phase<pg8::EpiInProj, pg8::Order, GEMM_ALIGN, GEMM_SP2>(lds, g, S, E);
            SEAM(pb + 0); DCHK(1);
        }
        if (INL(1)) for (int rep_ = 0; rep_ < REPS(1); ++rep_) { PHASE_ENV; for (int r3_ = 0; r3_ < ((PREPREP & 1) ? 2 : 1); ++r3_) qk_phase(pa, l); for (int r3_ = 0; r3_ < ((PREPREP & 2) ? 2 : 1); ++r3_) gla_prep_phase(pa, l, lds); SEAM(pb + 1);
#if defined(DIAG) && defined(DIAG2_MASK)
            if (((DIAG2_MASK >> 3) & 1) && l == DIAG_LAYER) { diag_check2(pa, l, 3); xcd_barrier(bar); }
#endif
        }
        if (INL(2)) for (int rep_ = 0; rep_ < REPS(2); ++rep_) { PHASE_ENV;
            {
                unsigned* qhead = (unsigned*)(ws + WS_CTL) + CW_QUEUE + 64 * (l + 4 * rep_);
                volatile LAS unsigned* qslot = (volatile LAS unsigned*)(lds + MISC_OFF) + 16;
                for (;;) {
                    if (tid == 0) qslot[0] = __hip_atomic_fetch_add(qhead, 1u, __ATOMIC_RELAXED, __HIP_MEMORY_SCOPE_AGENT);
                    __syncthreads();
                    const int item = (int)qslot[0];
                    __syncthreads();
                    if (item >= 592) break;
                    if (item < 48) { s5_chain(pa, l, item * 8 + wave, lds + wave * S5_LDS_PER_WAVE, lane); __syncthreads(); }
                    else if (item < 304) attn_unit(pa, item - 48, (char*)lds_raw);
                    else if (item < 560) gla_chain(pa, l, item - 304, lds);
                    else attn_unit(pa, 256 + (item - 560), (char*)lds_raw);
                }
            }
            SEAM(pb + 2);
#if defined(DIAG) && defined(DIAG2_MASK)
            if (l == DIAG_LAYER) { if ((DIAG2_MASK >> 4) & 1) diag_check2(pa, l, 4); if ((DIAG2_MASK >> 5) & 1) diag_check2(pa, l, 5); if ((DIAG2_MASK >> 6) & 1) diag_check2(pa, l, 6); xcd_barrier(bar); }
#endif
        }
        if (INL(3)) for (int rep_ = 0; rep_ < REPS(3); ++rep_) { PHASE_ENV; postmix_phase(pa, l, last); SEAM(pb + 3); DCHK(2); }
        if (INL(4)) for (int rep_ = 0; rep_ < REPS(4); ++rep_) { PHASE_ENV;
            pg8::Gemm g{(const bf16_t*)(ws + WS_YG), (const bf16_t*)(wl + WL_GLU), MROWS, 768, 768, 768, 768}; pg8::Order S; if (last) S.init_latent(768, 768, G, (int)blockIdx.x); else S.init_all(MROWS, 768, 768, G, (int)blockIdx.x);
            pg8::EpiGlu E{(const bf16_t*)(ws + WS_YG), (bf16_t*)(ws + WS_OCAT)};
            pg8::gemm_phase<pg8::EpiGlu, pg8::Order, true, true>(lds, g, S, E);
            SEAM(pb + 4); DCHK(3);
        }
        if (INL(5)) for (int rep_ = 0; rep_ < REPS(5); ++rep_) { PHASE_ENV;
            const bf16_t* OC = (const bf16_t*)(ws + WS_OCAT); const bf16_t* WC = (const bf16_t*)(wl + WL_CAT);
            { pg8::Gemm g{OC, WC, MROWS, DM, 2816, OCW, OCW}; pg8::Order S; S.init_merge(G, (int)blockIdx.x);
              pg8::EpiMergeRT E{(const bf16_t*)(ws + WS_Y), (float*)(ws + WS_T), (bf16_t*)(ws + WS_H)};
              pg8::gemm_phase<pg8::EpiMergeRT, pg8::Order, true, true>(lds, g, S, E); }
            if (!last) { pg8::Gemm g{OC, WC, MROWS, DM, 256, OCW, OCW}; pg8::Order S; S.init_ctx(DM, 11, 256, G, (int)blockIdx.x);
              pg8::EpiPartial E{(float*)(ws + WS_PART)};
              pg8::gemm_phase<pg8::EpiPartial, pg8::Order, true, true>(lds, g, S, E); }
            SEAM(pb + 5); DCHK(4);
        }
        if (INL(6)) for (int rep_ = 0; rep_ < REPS(6); ++rep_) { PHASE_ENV;
            if (!last) merge_ctx_combine(pa);
            { pg8::Gemm g{(const bf16_t*)(ws + WS_H), (const bf16_t*)(wl + WL_OUT), MROWS, DM, DM, DM, DM}; pg8::Order S; S.init_latent(DM, DM, G, (int)blockIdx.x);
              pg8::EpiResid E{(const float*)(ws + WS_X), (float*)(ws + WS_Z), modl + 2 * DM};
              pg8::gemm_phase<pg8::EpiResid, pg8::Order, true, true>(lds, g, S, E); }
            if (!last) { xcd_barrier(bar);
              pg8::Gemm g{(const bf16_t*)(ws + WS_H), (const bf16_t*)(wl + WL_OUT), MROWS, DM, 256, DM, DM}; pg8::Order S; S.init_ctx(DM, 8, 256, G, (int)blockIdx.x);
              pg8::EpiPartial E{(float*)(ws + WS_PART)};
              pg8::gemm_phase<pg8::EpiPartial, pg8::Order, true, true>(lds, g, S, E); }
            SEAM(pb + 6); DCHK(5);
        }
        if (INL(7)) for (int rep_ = 0; rep_ < REPS(7); ++rep_) { PHASE_ENV; ln_phase(pa, pa.in[I_LN1W] + l * DM, pa.in[I_LN1B] + l * DM, modl + 3 * DM, nullptr, modl + 2 * DM + 4 * (size_t)NMOD, last ? 0 : 8, last); SEAM(pb + 7); DCHK(6); }
        if (INL(8)) for (int rep_ = 0; rep_ < REPS(8); ++rep_) { PHASE_ENV;
            pg8::Gemm g{(const bf16_t*)(ws + WS_H), (const bf16_t*)(wl + WL_FFI), MROWS, 2 * DFF, DM, DM, DM}; pg8::Order S; if (last) S.init_latent(2 * DFF, DM, G, (int)blockIdx.x); else S.init_all(MROWS, 2 * DFF, DM, G, (int)blockIdx.x);
            pg8::EpiSwiglu E{(bf16_t*)(ws + WS_Y)};
            pg8::gemm_phase<pg8::EpiSwiglu, pg8::Order, GEMM_ALIGN, GEMM_SP2>(lds, g, S, E);
            SEAM(pb + 8); DCHK(7);
        }
        if (INL(9)) for (int rep_ = 0; rep_ < REPS(9); ++rep_) { PHASE_ENV;
            { pg8::Gemm g{(const bf16_t*)(ws + WS_Y), (const bf16_t*)(wl + WL_FFO), MROWS, DM, DFF, DFF, DFF}; pg8::Order S; S.init_latent(DM, DFF, G, (int)blockIdx.x);
              pg8::EpiResid E{(const float*)(ws + WS_X), (float*)(ws + WS_Z), modl + 5 * DM};
              pg8::gemm_phase<pg8::EpiResid, pg8::Order, true, true>(lds, g, S, E); }
            if (!last) { pg8::Gemm g{(const bf16_t*)(ws + WS_Y), (const bf16_t*)(wl + WL_FFO), MROWS, DM, 512, DFF, DFF}; pg8::Order S; S.init_ctx(DM, 11, 512, G, (int)blockIdx.x);
              pg8::EpiPartial E{(float*)(ws + WS_PART)};
              pg8::gemm_phase<pg8::EpiPartial, pg8::Order, true, true>(lds, g, S, E); }
            SEAM(pb + 9); DCHK(8);
        }
        if (INL(10)) for (int rep_ = 0; rep_ < REPS(10); ++rep_) { PHASE_ENV;
            if (!last) ln_phase(pa, pa.in[I_LN2W] + l * DM, pa.in[I_LN2B] + l * DM, MOD + (size_t)(l + 1) * 5 * NMOD, nullptr, modl + 5 * DM + 4 * (size_t)NMOD, 11, false);
            else ln_phase(pa, pa.in[I_LN2W] + l * DM, pa.in[I_LN2B] + l * DM, nullptr, pa.out, nullptr, 0, true);
            SEAM(pb + 10);
#ifdef DIAG
            if ((DIAG_MASK >> 9) & 1) { if (l == DIAG_LAYER) { if (!IN(pb + 11)) xcd_barrier(bar); diag_check(pa, l, 9); xcd_barrier(bar); } }
#endif
        }
    }
#ifdef DIAG
    xcd_barrier(bar); diag_report(args);
#endif
#undef IN
#undef INL
#undef INP
#undef SEAM
}

#ifndef MK_MULTI_LAUNCH
#define MK_MULTI_LAUNCH 0
#endif
extern "C" void kernel_launch(void* const* d_in, const int* in_sizes, int n_in, void* d_out, int out_size, void* d_ws, size_t ws_size, hipStream_t stream) {
    static int grid = 0;
    if (grid == 0) {
        if (n_in != 31 || out_size != NB * SEQ * DM || ws_size < WS_END) { fprintf(stderr, "kernel_launch: unexpected shapes (n_in %d out %d ws %zu, need %zu)\n", n_in, out_size, ws_size, (size_t)WS_END); grid = -1; return; }
        int dev = 0, cus = 0, per_cu = 0;
        if (hipGetDevice(&dev) != hipSuccess || hipDeviceGetAttribute(&cus, hipDeviceAttributeMultiprocessorCount, dev) != hipSuccess) { grid = -1; return; }
        if (hipFuncSetAttribute((const void*)fwd_kernel, hipFuncAttributeMaxDynamicSharedMemorySize, LDS_BYTES) != hipSuccess) { fprintf(stderr, "kernel_launch: hipFuncSetAttribute failed\n"); grid = -1; return; }
        if (hipOccupancyMaxActiveBlocksPerMultiprocessor(&per_cu, (const void*)fwd_kernel, NWAVES * 64, LDS_BYTES) != hipSuccess || per_cu < 1) fprintf(stderr, "kernel_launch: occupancy query says %d\n", per_cu);
        (void)hipGetLastError();
        grid = cus;
    }
    if (grid < 0) return;
    (void)hipMemsetAsync((char*)d_ws + WS_CTL, 0, CTL_ZERO_BYTES, stream);
    Args a{};
    for (int i = 0; i < 31; ++i) a.in[i] = (const float*)d_in[i];
    a.out = (float*)d_out; a.ws = (unsigned char*)d_ws;
#if MK_MULTI_LAUNCH
    for (int p = 0; p < NPH_TOTAL; ++p) { a.ph_lo = p; a.ph_hi = p + 1; hipLaunchKernelGGL(fwd_kernel, dim3(grid), dim3(NWAVES * 64), LDS_BYTES, stream, a); }
#else
    a.ph_lo = 0; a.ph_hi = NPH_TOTAL; hipLaunchKernelGGL(fwd_kernel, dim3(grid), dim3(NWAVES * 64), LDS_BYTES, stream, a);
#endif
    const hipError_t le = hipPeekAtLastError();
    if (le != hipSuccess) fprintf(stderr, "kernel_launch: launch failed: %s\n", hipGetErrorName(le));
}
```
